# Optimizing an MI355X kernel written in HIP

```python
import jax, jax.numpy as jnp
from jax import lax
import numpy as np

D_MODEL = 2048
BATCH = 8
SEQ = 2048
DEPTH = 2

CTX_LEN = 256
GRID_W = 64
N_BRANCH = 4
BRANCH_W = D_MODEL // N_BRANCH
GROUP_W = 128
N_GROUPS = BRANCH_W // GROUP_W
N_IN_SLICES = 8
IN_W = N_IN_SLICES * BRANCH_W
POOL_WINDOWS = (2, 4, 8, 16)
CHUNK = 128
CONV_W = 4
LRU_C = 8.0
NA_HEADS = N_GROUPS
NA_HEAD_DIM = GROUP_W
NA_WIN_R = 8
NA_WIN_C = 16
D_FF = -(-(8 * D_MODEL) // (3 * 256)) * 256
EPS = 1e-6
NEG_INF = -1e30

kernel_name = "hybrid_pool_sgu_rglru_natten_gated_merge"


def rms_norm(x, g):
    xf = x.astype(jnp.float32)
    y = xf * lax.rsqrt(jnp.mean(xf * xf, axis=-1, keepdims=True) + EPS)
    return (y * g.astype(jnp.float32)).astype(x.dtype)


def layer_norm(x, g):
    xf = x.astype(jnp.float32)
    xc = xf - jnp.mean(xf, axis=-1, keepdims=True)
    y = xc * lax.rsqrt(jnp.mean(xc * xc, axis=-1, keepdims=True) + EPS)
    return (y * g.astype(jnp.float32)).astype(x.dtype)


def adaln(cond, w_mod, b_mod):
    m = (jax.nn.silu(cond) @ w_mod + b_mod).reshape(cond.shape[:-1] + (6, D_MODEL))
    return tuple(jnp.expand_dims(m[..., i, :], -2) for i in range(6))


def modulate(xn, shift, scale):
    return xn * (1.0 + scale) + shift


def heads(z):
    return z.reshape(z.shape[0], z.shape[1], NA_HEADS, NA_HEAD_DIM)


def block_diag_linear(z, w, b):
    B, L, _ = z.shape
    y = jnp.einsum('blgc,gcd->blgd', z.reshape(B, L, N_GROUPS, GROUP_W), w)
    return y.reshape(B, L, BRANCH_W) + b


def pool_branch(z, w_pool, pool_scale):
    B, L, _ = z.shape
    zf = z.astype(jnp.float32)
    cs = jnp.concatenate([jnp.zeros((B, 1, BRANCH_W), jnp.float32), jnp.cumsum(zf, axis=1)], axis=1)
    t = jnp.arange(L)
    outs = []
    for gi, w in enumerate(POOL_WINDOWS):
        lo = jnp.clip(t - w // 2, 0, L)
        hi = jnp.clip(t + w // 2, 0, L)
        sl = slice(gi * GROUP_W, (gi + 1) * GROUP_W)
        csg = cs[..., sl]
        mean = (csg[:, hi] - csg[:, lo]) / (hi - lo).astype(jnp.float32)[None, :, None]
        outs.append(mean - zf[..., sl])
    pooled = jnp.concatenate(outs, axis=-1).astype(z.dtype)
    y = jnp.einsum('blgc,gcd->blgd', pooled.reshape(B, L, N_GROUPS, GROUP_W), w_pool)
    return y.reshape(B, L, BRANCH_W) * pool_scale


def spatial_gating(u, v, ln_g, w_sp, b_sp):
    B, L, _ = v.shape
    vn = layer_norm(v, ln_g).reshape(B, L // CHUNK, CHUNK, N_GROUPS, GROUP_W)
    mixed = jnp.einsum('gpq,bnqgc->bnpgc', w_sp, vn) + b_sp.T[None, None, :, :, None]
    return u * mixed.reshape(B, L, BRANCH_W)


def centred_depthwise_conv(z, w, b):
    L = z.shape[1]
    left = CONV_W // 2
    zp = jnp.pad(z, ((0, 0), (left, CONV_W - 1 - left), (0, 0)))
    out = zp[:, 0:L] * w[0] + b
    for k in range(1, CONV_W):
        out = out + zp[:, k:k + L] * w[k]
    return out


def _affine_combine(lhs, rhs):
    a_l, b_l = lhs
    a_r, b_r = rhs
    return a_l * a_r, a_r * b_l + b_r


def rg_lru(z, w_r, b_r, w_i, b_i, lam, h0, reverse):
    r = jax.nn.sigmoid(block_diag_linear(z, w_r, b_r).astype(jnp.float32))
    i = jax.nn.sigmoid(block_diag_linear(z, w_i, b_i).astype(jnp.float32))
    log_a = -LRU_C * r * jax.nn.softplus(-lam.astype(jnp.float32))
    a = jnp.exp(log_a)
    b = jnp.sqrt(-jnp.expm1(2.0 * log_a)) * (i * z.astype(jnp.float32))
    a_cum, b_cum = lax.associative_scan(_affine_combine, (a, b), axis=1, reverse=reverse)
    return a_cum * h0[:, None, :] + b_cum


def neighbourhood_attention(q, k, v, k_ctx, v_ctx, rpb):
    B, L, H, Dh = q.shape
    rows = L // GRID_W
    wr = min(NA_WIN_R, rows)
    r_idx = jnp.arange(rows)
    key_rows = jnp.clip(r_idx - wr // 2, 0, rows - wr)[:, None] + jnp.arange(wr)[None, :]
    col = jnp.arange(GRID_W)
    col_start = jnp.clip(col - NA_WIN_C // 2, 0, GRID_W - NA_WIN_C)
    col_ok = (col[None, :] >= col_start[:, None]) & (col[None, :] < col_start[:, None] + NA_WIN_C)
    qg = q.reshape(B, rows, GRID_W, H, Dh)
    kg = k.reshape(B, rows, GRID_W, H, Dh)[:, key_rows]
    vg = v.reshape(B, rows, GRID_W, H, Dh)[:, key_rows]
    scale = Dh ** -0.5
    s_loc = jnp.einsum('brqhd,brjkhd->brhqjk', qg, kg).astype(jnp.float32) * scale
    d_row = key_rows - r_idx[:, None] + (NA_WIN_R - 1)
    d_col = jnp.clip(col[None, :] - col[:, None] + (NA_WIN_C - 1), 0, 2 * NA_WIN_C - 2)
    bias = rpb[:, d_row[:, None, :, None], d_col[None, :, None, :]]
    s_loc = s_loc + jnp.moveaxis(bias, 0, 1)[None].astype(jnp.float32)
    s_loc = jnp.where(col_ok[:, None, :], s_loc, NEG_INF).reshape(B, rows, H, GRID_W, wr * GRID_W)
    s_ctx = jnp.einsum('brqhd,bkhd->brhqk', qg, k_ctx).astype(jnp.float32) * scale
    p = jax.nn.softmax(jnp.concatenate([s_loc, s_ctx], axis=-1), axis=-1).astype(q.dtype)
    p_loc = p[..., :wr * GRID_W].reshape(B, rows, H, GRID_W, wr, GRID_W)
    p_ctx = p[..., wr * GRID_W:]
    out = jnp.einsum('brhqjk,brjkhd->brqhd', p_loc, vg) + jnp.einsum('brhqk,bkhd->brqhd', p_ctx, v_ctx)
    return out.reshape(B, L, H * Dh)


def context_attention(q, k, v):
    B, C, H, Dh = q.shape
    s = jnp.einsum('bqhd,bkhd->bhqk', q, k).astype(jnp.float32) * (Dh ** -0.5)
    p = jax.nn.softmax(s, axis=-1).astype(q.dtype)
    return jnp.einsum('bhqk,bkhd->bqhd', p, v).reshape(B, C, H * Dh)


def merge_branches(h, ys, w_branch, w_gate, w_out):
    merged = jax.nn.sigmoid(h @ w_gate[:, 0]) * (ys[0] @ w_branch[0])
    for n in range(1, N_BRANCH):
        merged = merged + jax.nn.sigmoid(h @ w_gate[:, n]) * (ys[n] @ w_branch[n])
    return merged @ w_out


def swiglu(h, w_g, w_u, w_d):
    return (jax.nn.silu(h @ w_g) * (h @ w_u)) @ w_d


def setup_inputs(seed: int = 0) -> dict:
    key = jax.random.key(seed)
    ks = jax.random.split(key, 32)
    f32 = jnp.float32
    D = D_MODEL

    def nrm(k, shape, std):
        return jax.random.normal(k, shape, f32) * std

    a_c = jax.random.uniform(ks[21], (DEPTH, 2, BRANCH_W), f32, 0.9, 0.999)
    a_base = a_c ** (1.0 / LRU_C)
    return {
        "x": nrm(ks[0], (BATCH, SEQ, D), 1.0),
        "c": nrm(ks[1], (BATCH, D), 1.0),
        "ctx": nrm(ks[2], (BATCH, CTX_LEN, D), 1.0),
        "c_ctx": nrm(ks[3], (D,), 1.0),
        "w_mod": nrm(ks[4], (DEPTH, D, 6 * D), 0.5 * D ** -0.5),
        "b_mod": nrm(ks[5], (DEPTH, 6 * D), 0.02),
        "g_mix": 1.0 + nrm(ks[6], (DEPTH, D), 0.02),
        "g_ffn": 1.0 + nrm(ks[7], (DEPTH, D), 0.02),
        "g_final": 1.0 + nrm(ks[8], (D,), 0.02),
        "w_in": nrm(ks[9], (DEPTH, D, IN_W), D ** -0.5),
        "w_pool": nrm(ks[10], (DEPTH, N_GROUPS, GROUP_W, GROUP_W), GROUP_W ** -0.5),
        "pool_scale": 1.0 + nrm(ks[11], (DEPTH, BRANCH_W), 0.1),
        "gmlp_ln_g": 1.0 + nrm(ks[12], (DEPTH, BRANCH_W), 0.02),
        "w_sp": nrm(ks[13], (DEPTH, N_GROUPS, CHUNK, CHUNK), CHUNK ** -0.5),
        "b_sp": 1.0 + nrm(ks[14], (DEPTH, N_GROUPS, CHUNK), 0.1),
        "conv_w": nrm(ks[15], (DEPTH, CONV_W, BRANCH_W), CONV_W ** -0.5),
        "conv_b": nrm(ks[16], (DEPTH, BRANCH_W), 0.02),
        "w_rg": nrm(ks[17], (DEPTH, 2, N_GROUPS, GROUP_W, GROUP_W), GROUP_W ** -0.5),
        "b_rg": nrm(ks[18], (DEPTH, 2, BRANCH_W), 0.1),
        "w_ig": nrm(ks[19], (DEPTH, 2, N_GROUPS, GROUP_W, GROUP_W), GROUP_W ** -0.5),
        "b_ig": nrm(ks[20], (DEPTH, 2, BRANCH_W), 0.1),
        "lru_lam": jnp.log(a_base) - jnp.log1p(-a_base),
        "rpb": nrm(ks[22], (DEPTH, NA_HEADS, 2 * NA_WIN_R - 1, 2 * NA_WIN_C - 1), 0.1),
        "w_branch": nrm(ks[23], (DEPTH, N_BRANCH, BRANCH_W, D), BRANCH_W ** -0.5),
        "w_gate": nrm(ks[24], (DEPTH, D, N_BRANCH, D), D ** -0.5),
        "w_out": nrm(ks[25], (DEPTH, D, D), D ** -0.5),
        "w_ffn_gate": nrm(ks[26], (DEPTH, D, D_FF), D ** -0.5),
        "w_ffn_up": nrm(ks[27], (DEPTH, D, D_FF), D ** -0.5),
        "w_ffn_down": nrm(ks[28], (DEPTH, D_FF, D), D_FF ** -0.5),
    }


def reference(x, c, ctx, c_ctx, w_mod, b_mod, g_mix, g_ffn, g_final, w_in, w_pool, pool_scale,
              gmlp_ln_g, w_sp, b_sp, conv_w, conv_b, w_rg, b_rg, w_ig, b_ig, lru_lam, rpb,
              w_branch, w_gate, w_out, w_ffn_gate, w_ffn_up, w_ffn_down):
    B = x.shape[0]
    for l in range(DEPTH):
        last = l == DEPTH - 1
        sh1, sc1, gt1, sh2, sc2, gt2 = adaln(c, w_mod[l], b_mod[l])
        csh1, csc1, cgt1, csh2, csc2, cgt2 = adaln(c_ctx, w_mod[l], b_mod[l])

        hx = modulate(rms_norm(x, g_mix[l]), sh1, sc1)
        hc = modulate(rms_norm(ctx, g_mix[l]), csh1, csc1)
        x_pool, x_u, x_v, x_lru, x_lg, x_q, x_k, x_val = jnp.split(hx @ w_in[l], N_IN_SLICES, axis=-1)
        c_pool, c_u, c_v, c_lru, c_lg, c_q, c_k, c_val = jnp.split(hc @ w_in[l], N_IN_SLICES, axis=-1)

        k_ctx, v_ctx = heads(c_k), heads(c_val)
        c_conv = centred_depthwise_conv(c_lru, conv_w[l], conv_b[l])
        h_zero = jnp.zeros((B, BRANCH_W), jnp.float32)
        hc_f = rg_lru(c_conv, w_rg[l, 0], b_rg[l, 0], w_ig[l, 0], b_ig[l, 0], lru_lam[l, 0], h_zero, False)
        hc_b = rg_lru(c_conv, w_rg[l, 1], b_rg[l, 1], w_ig[l, 1], b_ig[l, 1], lru_lam[l, 1], h_zero, True)

        y_pool = pool_branch(x_pool, w_pool[l], pool_scale[l])
        y_sgu = spatial_gating(x_u, x_v, gmlp_ln_g[l], w_sp[l], b_sp[l])
        x_conv = centred_depthwise_conv(x_lru, conv_w[l], conv_b[l])
        hx_f = rg_lru(x_conv, w_rg[l, 0], b_rg[l, 0], w_ig[l, 0], b_ig[l, 0], lru_lam[l, 0], hc_f[:, -1], False)
        hx_b = rg_lru(x_conv, w_rg[l, 1], b_rg[l, 1], w_ig[l, 1], b_ig[l, 1], lru_lam[l, 1], hc_b[:, 0], True)
        y_lru = (hx_f + hx_b).astype(x.dtype) * jax.nn.gelu(x_lg)
        y_na = neighbourhood_attention(heads(x_q), heads(x_k), heads(x_val), k_ctx, v_ctx, rpb[l])
        x_mixed = x + gt1 * merge_branches(hx, [y_pool, y_sgu, y_lru, y_na], w_branch[l], w_gate[l], w_out[l])

        if not last:
            yc_pool = pool_branch(c_pool, w_pool[l], pool_scale[l])
            yc_sgu = spatial_gating(c_u, c_v, gmlp_ln_g[l], w_sp[l], b_sp[l])
            yc_lru = (hc_f + hc_b).astype(ctx.dtype) * jax.nn.gelu(c_lg)
            yc_na = context_attention(heads(c_q), k_ctx, v_ctx)
            ctx = ctx + cgt1 * merge_branches(hc, [yc_pool, yc_sgu, yc_lru, yc_na], w_branch[l], w_gate[l], w_out[l])
            hc2 = modulate(rms_norm(ctx, g_ffn[l]), csh2, csc2)
            ctx = ctx + cgt2 * swiglu(hc2, w_ffn_gate[l], w_ffn_up[l], w_ffn_down[l])

        hx2 = modulate(rms_norm(x_mixed, g_ffn[l]), sh2, sc2)
        x = x_mixed + gt2 * swiglu(hx2, w_ffn_gate[l], w_ffn_up[l], w_ffn_down[l])
    return rms_norm(x, g_final)
```

```cpp
#include <hip/hip_runtime.h>
#include <hip/hip_cooperative_groups.h>
#include <cstdio>
#include <cstdint>
namespace cg = cooperative_groups;

#define LAS __attribute__((address_space(3)))
typedef unsigned short bf16_t;
typedef short bf16x8 __attribute__((ext_vector_type(8)));
typedef float f32x4 __attribute__((ext_vector_type(4)));
typedef unsigned u32x4 __attribute__((ext_vector_type(4)));
typedef unsigned u32x2 __attribute__((ext_vector_type(2)));

constexpr int D = 2048, NB = 8, SEQ = 2048, CTXL = 256;
constexpr int MX = NB * SEQ, MC = NB * CTXL, MT = MX + MC;
constexpr int INW = 4096, DFF = 5632;
constexpr int NTHR = 512;
constexpr int LDS_BYTES = 147456;

constexpr size_t al256(size_t x) { return (x + 255) & ~(size_t)255; }
constexpr size_t WS_MOD   = 0;
constexpr size_t WS_AGG   = al256(WS_MOD + (size_t)2 * 9 * 12288 * 4);
constexpr size_t WS_SMALL = al256(WS_AGG + (size_t)2 * 8 * 18 * 512 * 2 * 4);
constexpr size_t SMALL_L  = (size_t)24 * 16384;
constexpr size_t WS_WIN   = al256(WS_SMALL + 2 * SMALL_L * 2);
constexpr size_t WS_GATE  = al256(WS_WIN + (size_t)4096 * 2048 * 2);
constexpr size_t WS_WB    = al256(WS_GATE + (size_t)8192 * 2048 * 2);
constexpr size_t WS_WO    = al256(WS_WB + (size_t)8192 * 512 * 2);
constexpr size_t WS_GU    = al256(WS_WO + (size_t)2048 * 2048 * 2);
constexpr size_t WS_WD    = al256(WS_GU + (size_t)11264 * 2048 * 2);
constexpr size_t WS_XR    = al256(WS_WD + (size_t)2048 * 5632 * 2);
constexpr size_t WS_H     = al256(WS_XR + (size_t)MT * D * 2);
constexpr size_t WS_Q     = al256(WS_H + (size_t)MT * D * 2);
constexpr size_t WS_YS    = al256(WS_Q + (size_t)MT * 8192 * 2);
constexpr size_t WS_VT    = al256(WS_YS + (size_t)MT * D * 2);
constexpr size_t WS_VTC   = al256(WS_VT + (size_t)NB * 4 * 128 * SEQ * 2);
constexpr size_t WS_AB    = al256(WS_VTC + (size_t)NB * 4 * 128 * CTXL * 2);
constexpr size_t WS_BAR   = al256(WS_AB + (size_t)MT * 2 * 512 * 4);
constexpr size_t WS_END   = al256(WS_BAR + 3456 * 4);

struct Params { const float* in[29]; float* out; unsigned char* ws; };
enum { I_X = 0, I_C, I_CTX, I_CCTX, I_WMOD, I_BMOD, I_GMIX, I_GFFN, I_GFINAL, I_WIN, I_WPOOL, I_PSCALE, I_LNG, I_WSP, I_BSP, I_CONVW, I_CONVB,
       I_WRG, I_BRG, I_WIG, I_BIG, I_LAM, I_RPB, I_WBR, I_WGATE, I_WOUT, I_WFG, I_WFU, I_WFD };

__device__ __forceinline__ unsigned cvt_pk_bf16(float lo, float hi) { unsigned r; asm volatile("v_cvt_pk_bf16_f32 %0, %1, %2" : "=v"(r) : "v"(lo), "v"(hi)); return r; }
__device__ __forceinline__ bf16_t f2bf(float f) { return (bf16_t)(cvt_pk_bf16(f, 0.f) & 0xffffu); }
__device__ __forceinline__ float bf2f(bf16_t b) { return __uint_as_float(((unsigned)b) << 16); }
__device__ __forceinline__ float bflo(unsigned u) { return __uint_as_float(u << 16); }
__device__ __forceinline__ float bfhi(unsigned u) { return __uint_as_float(u & 0xffff0000u); }
__device__ __forceinline__ float sigm(float x) { return __builtin_amdgcn_rcpf(1.f + __builtin_amdgcn_exp2f(-1.4426950408889634f * x)); }
__device__ __forceinline__ float fexp(float x) { return __builtin_amdgcn_exp2f(1.4426950408889634f * x); }
__device__ __forceinline__ float gelu_tanh(float x) { const float u = 0.7978845608028654f * (x + 0.044715f * x * x * x); return x * sigm(2.f * u); }
__device__ __forceinline__ int otid() { int t = threadIdx.x; asm volatile("" : "+v"(t)); return t; }
__device__ __forceinline__ int obid() { int t = blockIdx.x; asm volatile("" : "+s"(t)); return t; }
__device__ __forceinline__ float wave_sum(float v) {
#pragma unroll
    for (int o = 32; o >= 1; o >>= 1) v += __shfl_xor(v, o);
    return v;
}

namespace pg8 {
constexpr int BM = 256, BK = 64, HALF = 128, HTB = HALF * BK * 2, STAGE_BYTES = 8 * HTB, NXCD = 8, WGM = 8;
__device__ __forceinline__ int lds_byte(int r, int c) { const int st = (r >> 4) * 2 + (c >> 5), rr = r & 15, cc = c & 31, ob = rr * 64 + cc * 2; return st * 1024 + (ob ^ (((ob >> 9) & 1) << 5)); }
__device__ __forceinline__ void stage_rc(int b, int& R, int& C) { const int st = b / 1024, sb = b % 1024, swz = sb ^ (((sb >> 9) & 1) << 5); R = (st >> 1) * 16 + swz / 64; C = (st & 1) * 32 + (swz % 64) / 2; }
__device__ __forceinline__ int perm32(int rho) { const int n = rho >> 4, i = rho & 15; return 8 * (i >> 2) + 4 * n + (i & 3); }

struct Unit { int pm, pn; };
struct Gemm { const bf16_t* A; const bf16_t* Bt; int lda; int a_grp_bytes; int M, N, K; int wgm; };

struct StaticOrder {
    int nM, nN, nwg, G, c, wgm;
    __device__ void init(int M, int N, int G_, int c_, int w_) { nM = M / BM; nN = N / BM; nwg = nM * nN; G = G_; c = c_; wgm = w_; }
    __device__ bool next(int i, Unit& u) const {
        const long L = (long)i * G + c; if (L >= nwg) return false;
        int wgid = (int)L; { const int q = nwg / NXCD, r = nwg % NXCD, xcd = wgid % NXCD, off = wgid / NXCD; wgid = (xcd < r ? xcd * (q + 1) : r * (q + 1) + (xcd - r) * q) + off; }
        const int nig = wgm * nN, gid = wgid / nig, fm = gid * wgm, gsz = (nM - fm) < wgm ? (nM - fm) : wgm;
        u.pm = fm + ((wgid % nig) % gsz); u.pn = (wgid % nig) / gsz; return true;
    }
};


struct EpiStore {
    static constexpr bool PERM = true;
    bf16_t* O; int ldc; int vt_pn; bf16_t* VT; bf16_t* VTC;
    __device__ __forceinline__ void operator()(const f32x4 (&acc)[2][2][4][2], const Unit& u, int wr, int wc, int fr, int fq) const {
        if (u.pn < vt_pn) {
            const int row0 = u.pm * BM + wr * 64 + fr, col0 = u.pn * BM + wc * 32 + 8 * fq;
#pragma unroll
            for (int ai = 0; ai < 2; ++ai)
#pragma unroll
                for (int m = 0; m < 4; ++m) { bf16_t* rowp = O + (size_t)(row0 + ai * HALF + m * 16) * ldc + col0;
#pragma unroll
                    for (int bj = 0; bj < 2; ++bj) { const f32x4 v0 = acc[ai][bj][m][0], v1 = acc[ai][bj][m][1];
                        u32x4 o; o[0] = cvt_pk_bf16(v0[0], v0[1]); o[1] = cvt_pk_bf16(v0[2], v0[3]); o[2] = cvt_pk_bf16(v1[0], v1[1]); o[3] = cvt_pk_bf16(v1[2], v1[3]);
                        *(u32x4*)(rowp + bj * HALF) = o; } }
        } else {
            const bool isx = u.pm < 64;
            const int b = isx ? (u.pm >> 3) : (u.pm - 64);
            const int tb = isx ? (u.pm & 7) * 256 : 0;
            const int tlen = isx ? SEQ : CTXL;
            bf16_t* base = isx ? VT : VTC;
#pragma unroll
            for (int bj = 0; bj < 2; ++bj)
#pragma unroll
                for (int n = 0; n < 2; ++n)
#pragma unroll
                    for (int j = 0; j < 4; ++j) {
                        const int hd = (u.pn - vt_pn) * BM + bj * HALF + wc * 32 + 8 * fq + 4 * n + j;
                        bf16_t* colp = base + ((size_t)b * 512 + hd) * tlen + tb + wr * 64 + fr;
#pragma unroll
                        for (int ai = 0; ai < 2; ++ai)
#pragma unroll
                            for (int m = 0; m < 4; ++m) colp[ai * HALF + m * 16] = f2bf(acc[ai][bj][m][n][j]);
                    }
        }
    }
};
struct EpiGate {
    static constexpr bool PERM = false;
    const bf16_t* P; bf16_t* O;
    __device__ __forceinline__ void operator()(const f32x4 (&acc)[2][2][4][2], const Unit& u, int wr, int wc, int fr, int fq) const {
        const int row0 = u.pm * BM + wr * 64 + fr, col = u.pn * 64 + wc * 16 + 4 * fq;
        const bf16_t* pb = P + (size_t)row0 * 8192 + col;
        u32x2 pv[2][4][4];
#pragma unroll
        for (int ai = 0; ai < 2; ++ai)
#pragma unroll
            for (int m = 0; m < 4; ++m)
#pragma unroll
                for (int br = 0; br < 4; ++br) pv[ai][m][br] = *(const u32x2*)(pb + (size_t)(ai * HALF + m * 16) * 8192 + br * 2048);
        __builtin_amdgcn_sched_barrier(0);
        f32x4 sg[2][2][4][2];
#pragma unroll
        for (int ai = 0; ai < 2; ++ai)
#pragma unroll
            for (int bj = 0; bj < 2; ++bj)
#pragma unroll
                for (int m = 0; m < 4; ++m)
#pragma unroll
                    for (int n = 0; n < 2; ++n) { const f32x4 a = acc[ai][bj][m][n]; f32x4 r; r[0] = sigm(a[0]); r[1] = sigm(a[1]); r[2] = sigm(a[2]); r[3] = sigm(a[3]); sg[ai][bj][m][n] = r; }
        __builtin_amdgcn_sched_barrier(0);
#pragma unroll
        for (int ai = 0; ai < 2; ++ai)
#pragma unroll
            for (int m = 0; m < 4; ++m) {
                const size_t row = (size_t)(row0 + ai * HALF + m * 16);
                float s0 = 0.f, s1 = 0.f, s2 = 0.f, s3 = 0.f;
#pragma unroll
                for (int bj = 0; bj < 2; ++bj)
#pragma unroll
                    for (int n = 0; n < 2; ++n) {
                        const u32x2 pq = pv[ai][m][bj * 2 + n];
                        const f32x4 a = sg[ai][bj][m][n];
                        s0 += a[0] * bflo(pq[0]); s1 += a[1] * bfhi(pq[0]); s2 += a[2] * bflo(pq[1]); s3 += a[3] * bfhi(pq[1]);
                    }
                u32x2 o; o[0] = cvt_pk_bf16(s0, s1); o[1] = cvt_pk_bf16(s2, s3);
                *(u32x2*)(O + row * 2048 + col) = o;
            }
    }
};
struct EpiRes {
    static constexpr bool PERM = true;
    bf16_t* XR; const float* gate; const float* srcx; const float* srcc;
    __device__ __forceinline__ void operator()(const f32x4 (&acc)[2][2][4][2], const Unit& u, int wr, int wc, int fr, int fq) const {
        const int brow = u.pm < 64 ? (u.pm >> 3) : 8;
        const int row0 = u.pm * BM + wr * 64 + fr, col0 = u.pn * BM + wc * 32 + 8 * fq;
        const float* gp = gate + (size_t)brow * 12288 + col0;
        f32x4 gv[2][2];
#pragma unroll
        for (int bj = 0; bj < 2; ++bj)
#pragma unroll
            for (int n = 0; n < 2; ++n) gv[bj][n] = *(const f32x4*)(gp + bj * HALF + n * 4);
        if (srcx) {
            const float* sb = u.pm < 64 ? srcx + (size_t)row0 * D : srcc + (size_t)(row0 - MX) * D;
#pragma unroll
            for (int ai = 0; ai < 2; ++ai)
#pragma unroll
                for (int m = 0; m < 4; ++m) { const size_t ro = (size_t)(ai * HALF + m * 16) * D + col0;
#pragma unroll
                    for (int bj = 0; bj < 2; ++bj) {
                        const f32x4 x0 = *(const f32x4*)(sb + ro + bj * HALF), x1 = *(const f32x4*)(sb + ro + bj * HALF + 4);
                        const f32x4 y0 = x0 + gv[bj][0] * acc[ai][bj][m][0], y1 = x1 + gv[bj][1] * acc[ai][bj][m][1];
                        u32x4 o; o[0] = cvt_pk_bf16(y0[0], y0[1]); o[1] = cvt_pk_bf16(y0[2], y0[3]); o[2] = cvt_pk_bf16(y1[0], y1[1]); o[3] = cvt_pk_bf16(y1[2], y1[3]);
                        *(u32x4*)(XR + (size_t)row0 * D + ro + bj * HALF) = o; } }
        } else {
            bf16_t* xb = XR + (size_t)row0 * D + col0;
            u32x4 xv[2][4][2];
#pragma unroll
            for (int ai = 0; ai < 2; ++ai)
#pragma unroll
                for (int m = 0; m < 4; ++m)
#pragma unroll
                    for (int bj = 0; bj < 2; ++bj) xv[ai][m][bj] = *(const u32x4*)(xb + (size_t)(ai * HALF + m * 16) * D + bj * HALF);
            __builtin_amdgcn_sched_barrier(0);
#pragma unroll
            for (int ai = 0; ai < 2; ++ai)
#pragma unroll
                for (int m = 0; m < 4; ++m)
#pragma unroll
                    for (int bj = 0; bj < 2; ++bj) {
                        const u32x4 x = xv[ai][m][bj]; const f32x4 a0 = acc[ai][bj][m][0], a1 = acc[ai][bj][m][1]; const f32x4 g0 = gv[bj][0], g1 = gv[bj][1];
                        u32x4 o;
                        o[0] = cvt_pk_bf16(bflo(x[0]) + g0[0] * a0[0], bfhi(x[0]) + g0[1] * a0[1]); o[1] = cvt_pk_bf16(bflo(x[1]) + g0[2] * a0[2], bfhi(x[1]) + g0[3] * a0[3]);
                        o[2] = cvt_pk_bf16(bflo(x[2]) + g1[0] * a1[0], bfhi(x[2]) + g1[1] * a1[1]); o[3] = cvt_pk_bf16(bflo(x[3]) + g1[2] * a1[2], bfhi(x[3]) + g1[3] * a1[3]);
                        *(u32x4*)(xb + (size_t)(ai * HALF + m * 16) * D + bj * HALF) = o;
                    }
        }
    }
};
struct EpiSwi {
    static constexpr bool PERM = true;
    bf16_t* O;
    __device__ __forceinline__ void operator()(const f32x4 (&acc)[2][2][4][2], const Unit& u, int wr, int wc, int fr, int fq) const {
        const int row0 = u.pm * BM + wr * 64 + fr, col0 = u.pn * HALF + wc * 32 + 8 * fq;
#pragma unroll
        for (int ai = 0; ai < 2; ++ai)
#pragma unroll
            for (int m = 0; m < 4; ++m) {
                float v[8];
#pragma unroll
                for (int n = 0; n < 2; ++n)
#pragma unroll
                    for (int j = 0; j < 4; ++j) { const float g = acc[ai][0][m][n][j], uu = acc[ai][1][m][n][j]; v[n * 4 + j] = g * sigm(g) * uu; }
                u32x4 o; o[0] = cvt_pk_bf16(v[0], v[1]); o[1] = cvt_pk_bf16(v[2], v[3]); o[2] = cvt_pk_bf16(v[4], v[5]); o[3] = cvt_pk_bf16(v[6], v[7]);
                *(u32x4*)(O + (size_t)(row0 + ai * HALF + m * 16) * DFF + col0) = o;
            }
    }
};

template <class Epi>
__device__ __forceinline__ void gemm_phase(LAS unsigned char* lds, const Gemm g, const Epi& E) {
    const int tid = otid(), wid = __builtin_amdgcn_readfirstlane(tid >> 6), lane = tid & 63, wr = wid >> 2, wc = wid & 3, fr = lane & 15, fq = lane >> 4;
    const int K = g.K, nt = K / BK;
    StaticOrder S; S.init(g.M, g.N, gridDim.x, obid(), g.wgm);
    unsigned voffA[2], voffB[2];
#pragma unroll
    for (int i = 0; i < 2; ++i) { int R, C; stage_rc(tid * 16 + i * 8192, R, C); const int Rb = Epi::PERM ? ((R & ~31) + perm32(R & 31)) : R;
        voffA[i] = (unsigned)(R * g.lda + C) * 2u; voffB[i] = (unsigned)(Rb * K + C) * 2u; }
    const size_t kstep = (size_t)(BK * 2);
    const size_t hstepA = (size_t)HALF * g.lda * 2, tstepA = 2 * hstepA;
    const size_t hstepB = (size_t)HALF * K * 2, tstepB = 2 * hstepB;
    const unsigned ldsw = (unsigned)wid * 1024u;
    const int aoff = lds_byte(wr * 64 + fr, fq * 8), boff = lds_byte(wc * 32 + fr, fq * 8);
#define PG8_SA(b, h) (((b) * 2 + (h)) * HTB)
#define PG8_SB(b, h) ((4 + (b) * 2 + (h)) * HTB)
#define PG8_STAGE(bufoff, gbase, voff) do { _Pragma("unroll") for (int _i = 0; _i < 2; ++_i) \
        __builtin_amdgcn_global_load_lds((const unsigned*)((const char*)(gbase) + (voff)[_i]), (LAS unsigned*)(lds + (bufoff) + ldsw + _i * 8192), 16, 0, 0); } while (0)
#define PG8_LDA(dst, b, h) do { _Pragma("unroll") for (int m = 0; m < 4; ++m) _Pragma("unroll") for (int k = 0; k < 2; ++k) dst[m][k] = *(const LAS bf16x8*)(lds + PG8_SA(b, h) + aoff + m * 2048 + k * 1024); } while (0)
#define PG8_LDB(dst, b, h) do { _Pragma("unroll") for (int n = 0; n < 2; ++n) _Pragma("unroll") for (int k = 0; k < 2; ++k) dst[n][k] = *(const LAS bf16x8*)(lds + PG8_SB(b, h) + boff + n * 2048 + k * 1024); } while (0)
#define PG8_MMA(ai, bj, At, Bt) do { __builtin_amdgcn_s_setprio(3); _Pragma("unroll") for (int m = 0; m < 4; ++m) _Pragma("unroll") for (int n = 0; n < 2; ++n) _Pragma("unroll") for (int k = 0; k < 2; ++k) \
        acc[ai][bj][m][n] = __builtin_amdgcn_mfma_f32_16x16x32_bf16(Bt[n][k], At[m][k], acc[ai][bj][m][n], 0, 0, 0); __builtin_amdgcn_s_setprio(0); } while (0)
#define PG8_WAIT_V(n) asm volatile("s_waitcnt vmcnt(" #n ")" ::: "memory")
#define PG8_WAIT_L(n) asm volatile("s_waitcnt lgkmcnt(" #n ")" ::: "memory")
#define PG8_BAR __builtin_amdgcn_s_barrier()
#define PG8_SCHED __builtin_amdgcn_sched_barrier(0)
    Unit cur, nxt; int ui = 0;
    if (!S.next(0, cur)) return;
    f32x4 acc[2][2][4][2];
#pragma unroll
    for (int a = 0; a < 2; ++a)
#pragma unroll
        for (int b = 0; b < 2; ++b)
#pragma unroll
            for (int m = 0; m < 4; ++m)
#pragma unroll
                for (int n = 0; n < 2; ++n) acc[a][b][m][n] = (f32x4){0.f, 0.f, 0.f, 0.f};
    bf16x8 At[4][2], B0[2][2], B1[2][2];
    const char* cA = (const char*)g.A + (size_t)cur.pm * tstepA + (size_t)(cur.pn >> 3) * g.a_grp_bytes; const char* cB = (const char*)g.Bt + (size_t)cur.pn * tstepB;
    PG8_STAGE(PG8_SB(0, 0), cB, voffB); PG8_STAGE(PG8_SB(0, 1), cB + hstepB, voffB); PG8_STAGE(PG8_SA(0, 0), cA, voffA); PG8_STAGE(PG8_SA(0, 1), cA + hstepA, voffA);
    if (wr == 1) PG8_BAR;
    PG8_WAIT_V(2); PG8_BAR;
    PG8_STAGE(PG8_SB(1, 0), cB + kstep, voffB); PG8_STAGE(PG8_SA(1, 0), cA + kstep, voffA); PG8_STAGE(PG8_SB(1, 1), cB + hstepB + kstep, voffB);
    PG8_WAIT_V(6); PG8_BAR;
    for (;;) {
        const bool has_next = S.next(ui + 1, nxt);
        const char* nA = has_next ? (const char*)g.A + (size_t)nxt.pm * tstepA + (size_t)(nxt.pn >> 3) * g.a_grp_bytes : cA; const char* nB = has_next ? (const char*)g.Bt + (size_t)nxt.pn * tstepB : cB;
        for (int t = 0; t < nt; t += 2) {
            const bool last = (t == nt - 2);
            const char* a1 = cA + (size_t)(t + 1) * kstep;
            const char* a2 = last ? nA : cA + (size_t)(t + 2) * kstep; const char* b2 = last ? nB : cB + (size_t)(t + 2) * kstep;
            const char* a3 = a2 + kstep; const char* b3 = b2 + kstep;
            PG8_LDB(B0, 0, 0); PG8_LDB(B1, 0, 1); PG8_SCHED; PG8_LDA(At, 0, 0); PG8_STAGE(PG8_SA(1, 1), a1 + hstepA, voffA);
            PG8_WAIT_V(8); PG8_WAIT_L(0); PG8_BAR; PG8_MMA(0, 0, At, B0); PG8_MMA(0, 1, At, B1); PG8_BAR; PG8_SCHED;
            PG8_LDA(At, 0, 1); PG8_STAGE(PG8_SB(0, 0), b2, voffB); PG8_STAGE(PG8_SB(0, 1), b2 + hstepB, voffB); PG8_STAGE(PG8_SA(0, 0), a2, voffA);
            PG8_WAIT_V(8); PG8_WAIT_L(0); PG8_BAR; PG8_MMA(1, 0, At, B0); PG8_MMA(1, 1, At, B1); PG8_BAR; PG8_SCHED;
            PG8_LDB(B0, 1, 0); PG8_LDB(B1, 1, 1); PG8_SCHED; PG8_LDA(At, 1, 0); PG8_STAGE(PG8_SA(0, 1), a2 + hstepA, voffA);
            PG8_WAIT_V(8); PG8_WAIT_L(0); PG8_BAR; PG8_MMA(0, 0, At, B0); PG8_MMA(0, 1, At, B1); PG8_BAR; PG8_SCHED;
            PG8_LDA(At, 1, 1); PG8_STAGE(PG8_SB(1, 0), b3, voffB); PG8_STAGE(PG8_SB(1, 1), b3 + hstepB, voffB); PG8_STAGE(PG8_SA(1, 0), a3, voffA);
            PG8_WAIT_V(8); PG8_WAIT_L(0); PG8_BAR; PG8_MMA(1, 0, At, B0); PG8_MMA(1, 1, At, B1); PG8_BAR; PG8_SCHED;
        }
        if (wr == 0) PG8_BAR;
        E(acc, cur, wr, wc, fr, fq);
        if (!has_next) break;
#pragma unroll
        for (int a = 0; a < 2; ++a)
#pragma unroll
            for (int b = 0; b < 2; ++b)
#pragma unroll
                for (int m = 0; m < 4; ++m)
#pragma unroll
                    for (int n = 0; n < 2; ++n) acc[a][b][m][n] = (f32x4){0.f, 0.f, 0.f, 0.f};
        cur = nxt; cA = nA; cB = nB; ++ui;
        if (wr == 1) PG8_BAR;
    }
    PG8_WAIT_V(0);
    PG8_BAR;
#undef PG8_SA
#undef PG8_SB
#undef PG8_STAGE
#undef PG8_LDA
#undef PG8_LDB
#undef PG8_MMA
#undef PG8_WAIT_V
#undef PG8_WAIT_L
#undef PG8_BAR
#undef PG8_SCHED
}
}

template <int MODE>
__device__ __forceinline__ const float* conv_src(const float* src, const float* src2, int R) {
    if (MODE == 0) return src + R;
    if (MODE == 1) { const int pn = R >> 8, rho = R & 255; const int br = ((rho >> 7) << 1) | ((rho >> 4) & 1); const int c = pn * 64 + ((rho >> 5) & 3) * 16 + (rho & 15); return src + br * 2048 + c; }
    const int pn = R >> 8, rho = R & 255; return ((rho >> 7) ? src2 : src) + pn * 128 + (rho & 127);
}
template <int MODE>
__device__ __forceinline__ void conv_T(const float* src, const float* src2, int src_ld, bf16_t* dst, int K, int NR, LAS float* lds) {
    const int tid = otid();
    const int kt = K >> 7, ntiles = (NR >> 6) * kt;
    const int rr = tid & 63, kk0 = tid >> 6, kp = tid & 15, rr0 = tid >> 4;
    float v[16];
    int tl = obid();
    if (tl < ntiles) {
        const int R0 = (tl / kt) << 6, k0 = (tl % kt) << 7;
        const float* sp = conv_src<MODE>(src, src2, R0 + rr) + (size_t)(k0 + kk0) * src_ld;
#pragma unroll
        for (int i = 0; i < 16; ++i) v[i] = sp[(size_t)(8 * i) * src_ld];
    }
    for (int it = 0; tl < ntiles; tl += gridDim.x, ++it) {
        LAS float* tile = lds + (it & 1) * (128 * 65);
#pragma unroll
        for (int i = 0; i < 16; ++i) tile[(kk0 + 8 * i) * 65 + rr] = v[i];
        const int tn = tl + gridDim.x;
        if (tn < ntiles) {
            const int R0n = (tn / kt) << 6, k0n = (tn % kt) << 7;
            const float* sp = conv_src<MODE>(src, src2, R0n + rr) + (size_t)(k0n + kk0) * src_ld;
#pragma unroll
            for (int i = 0; i < 16; ++i) v[i] = sp[(size_t)(8 * i) * src_ld];
        }
        __syncthreads();
        const int R0 = (tl / kt) << 6, k0 = (tl % kt) << 7;
#pragma unroll
        for (int i = 0; i < 2; ++i) {
            const int r = rr0 + 32 * i;
            float f[8];
#pragma unroll
            for (int j = 0; j < 8; ++j) f[j] = tile[(8 * kp + j) * 65 + r];
            u32x4 o; o[0] = cvt_pk_bf16(f[0], f[1]); o[1] = cvt_pk_bf16(f[2], f[3]); o[2] = cvt_pk_bf16(f[4], f[5]); o[3] = cvt_pk_bf16(f[6], f[7]);
            *(u32x4*)(dst + (size_t)(R0 + r) * K + k0 + 8 * kp) = o;
        }
    }
    __syncthreads();
}

__device__ void convert_layer(const Params& p, int l, LAS float* tile) {
    unsigned char* ws = p.ws;
    conv_T<0>(p.in[I_WIN] + (size_t)l * D * INW, nullptr, INW, (bf16_t*)(ws + WS_WIN), D, INW, tile);
    conv_T<1>(p.in[I_WGATE] + (size_t)l * D * 8192, nullptr, 8192, (bf16_t*)(ws + WS_GATE), D, 8192, tile);
    for (int n = 0; n < 4; ++n)
        conv_T<0>(p.in[I_WBR] + ((size_t)l * 4 + n) * 512 * D, nullptr, D, (bf16_t*)(ws + WS_WB) + (size_t)n * 2048 * 512, 512, D, tile);
    conv_T<0>(p.in[I_WOUT] + (size_t)l * D * D, nullptr, D, (bf16_t*)(ws + WS_WO), D, D, tile);
    conv_T<2>(p.in[I_WFG] + (size_t)l * D * DFF, p.in[I_WFU] + (size_t)l * D * DFF, DFF, (bf16_t*)(ws + WS_GU), D, 2 * DFF, tile);
    conv_T<0>(p.in[I_WFD] + (size_t)l * DFF * D, nullptr, D, (bf16_t*)(ws + WS_WD), DFF, D, tile);
    bf16_t* sm = (bf16_t*)(ws + WS_SMALL) + (size_t)l * SMALL_L;
    for (int gI = 0; gI < 4; ++gI) conv_T<0>(p.in[I_WPOOL] + ((size_t)l * 4 + gI) * 16384, nullptr, 128, sm + (size_t)gI * 16384, 128, 128, tile);
    for (int gI = 0; gI < 8; ++gI) conv_T<0>(p.in[I_WRG] + ((size_t)l * 8 + gI) * 16384, nullptr, 128, sm + (size_t)(4 + gI) * 16384, 128, 128, tile);
    for (int gI = 0; gI < 8; ++gI) conv_T<0>(p.in[I_WIG] + ((size_t)l * 8 + gI) * 16384, nullptr, 128, sm + (size_t)(12 + gI) * 16384, 128, 128, tile);
    {
        const float* s = p.in[I_WSP] + (size_t)l * 65536; bf16_t* d = sm + (size_t)20 * 16384;
        for (int i = obid() * NTHR + otid(); i < 32768; i += gridDim.x * NTHR) *(unsigned*)(d + 2 * i) = cvt_pk_bf16(s[2 * i], s[2 * i + 1]);
    }
}

__device__ void phase_mod(const Params& p, LAS float* lds) {
    const int tid = otid();
    LAS float* cond = lds; LAS float* red = lds + 9 * 2048;
    for (int i = tid; i < 9 * 2048; i += NTHR) { const int r = i >> 11, k = i & 2047; const float v = r < 8 ? p.in[I_C][r * 2048 + k] : p.in[I_CCTX][k]; cond[i] = v * sigm(v); }
    __syncthreads();
    float* mod = (float*)(p.ws + WS_MOD);
    for (int chunk = obid(); chunk < 256; chunk += gridDim.x) {
        const int l = chunk >> 7, col0 = (chunk & 127) * 96;
        const float* W = p.in[I_WMOD] + (size_t)l * 2048 * 12288;
        if (tid < 384) {
            const int q = tid % 24, kg = tid / 24;
            float acc[9][4];
#pragma unroll
            for (int r = 0; r < 9; ++r)
#pragma unroll
                for (int j = 0; j < 4; ++j) acc[r][j] = 0.f;
            const float* wp = W + (size_t)(kg * 128) * 12288 + col0 + 4 * q;
#pragma unroll 8
            for (int kk = 0; kk < 128; ++kk) {
                const f32x4 w = *(const f32x4*)(wp + (size_t)kk * 12288);
#pragma unroll
                for (int r = 0; r < 9; ++r) { const float cv = cond[r * 2048 + kg * 128 + kk];
#pragma unroll
                    for (int j = 0; j < 4; ++j) acc[r][j] += cv * w[j]; }
            }
#pragma unroll
            for (int r = 0; r < 9; ++r)
#pragma unroll
                for (int j = 0; j < 4; ++j) red[kg * 864 + q * 36 + r * 4 + j] = acc[r][j];
        }
        __syncthreads();
        for (int o = tid; o < 864; o += NTHR) {
            const int r = o / 96, cc = o % 96, q = cc >> 2, j = cc & 3;
            float s = p.in[I_BMOD][l * 12288 + col0 + cc];
#pragma unroll
            for (int kg = 0; kg < 16; ++kg) s += red[kg * 864 + q * 36 + r * 4 + j];
            mod[((size_t)l * 9 + r) * 12288 + col0 + cc] = s;
        }
        __syncthreads();
    }
}

template <bool F32SRC>
__device__ void phase_norm(const float* xsrc, const float* csrc, const bf16_t* XRb, const float* gamma, const float* modl, int shi, int sci, bf16_t* H, int nrows) {
    const int tid_ = otid(); const int lane = tid_ & 63, gw = obid() * 8 + (tid_ >> 6), nw = gridDim.x * 8;
    for (int row = gw; row < nrows; row += nw) {
        const int brow = row < MX ? (row >> 11) : 8;
        float v[32]; float ss = 0.f;
        if (F32SRC) {
            const float* src = row < MX ? xsrc + (size_t)row * D : csrc + (size_t)(row - MX) * D;
#pragma unroll
            for (int i = 0; i < 4; ++i) { const f32x4 a = *(const f32x4*)(src + 8 * (lane + 64 * i)), b = *(const f32x4*)(src + 8 * (lane + 64 * i) + 4);
#pragma unroll
                for (int j = 0; j < 4; ++j) { v[8 * i + j] = a[j]; v[8 * i + 4 + j] = b[j]; } }
        } else {
#pragma unroll
            for (int i = 0; i < 4; ++i) { const u32x4 a = *(const u32x4*)(XRb + (size_t)row * D + 8 * (lane + 64 * i));
#pragma unroll
                for (int j = 0; j < 4; ++j) { v[8 * i + 2 * j] = bflo(a[j]); v[8 * i + 2 * j + 1] = bfhi(a[j]); } }
        }
#pragma unroll
        for (int i = 0; i < 32; ++i) ss += v[i] * v[i];
        ss = wave_sum(ss);
        const float rstd = rsqrtf(ss * (1.f / D) + 1e-6f);
        const float* shp = modl + (size_t)brow * 12288 + shi * 2048; const float* scp = modl + (size_t)brow * 12288 + sci * 2048;
#pragma unroll
        for (int i = 0; i < 4; ++i) {
            const int col = 8 * (lane + 64 * i);
            float y[8];
#pragma unroll
            for (int hh = 0; hh < 2; ++hh) { const f32x4 g = *(const f32x4*)(gamma + col + 4 * hh), sc = *(const f32x4*)(scp + col + 4 * hh), sh = *(const f32x4*)(shp + col + 4 * hh);
#pragma unroll
                for (int j = 0; j < 4; ++j) y[4 * hh + j] = v[8 * i + 4 * hh + j] * rstd * g[j] * (1.f + sc[j]) + sh[j]; }
            u32x4 o; o[0] = cvt_pk_bf16(y[0], y[1]); o[1] = cvt_pk_bf16(y[2], y[3]); o[2] = cvt_pk_bf16(y[4], y[5]); o[3] = cvt_pk_bf16(y[6], y[7]);
            *(u32x4*)(H + (size_t)row * D + col) = o;
        }
    }
}
__device__ void phase_final(const bf16_t* XRb, const float* gamma, float* out) {
    const int tid_ = otid(); const int lane = tid_ & 63, gw = obid() * 8 + (tid_ >> 6), nw = gridDim.x * 8;
    for (int row = gw; row < MX; row += nw) {
        float v[32]; float ss = 0.f;
#pragma unroll
        for (int i = 0; i < 4; ++i) { const u32x4 a = *(const u32x4*)(XRb + (size_t)row * D + 8 * (lane + 64 * i));
#pragma unroll
            for (int j = 0; j < 4; ++j) { v[8 * i + 2 * j] = bflo(a[j]); v[8 * i + 2 * j + 1] = bfhi(a[j]); } }
#pragma unroll
        for (int i = 0; i < 32; ++i) ss += v[i] * v[i];
        ss = wave_sum(ss);
        const float rstd = rsqrtf(ss * (1.f / D) + 1e-6f);
#pragma unroll
        for (int i = 0; i < 4; ++i) { const int col = 8 * (lane + 64 * i);
#pragma unroll
            for (int hh = 0; hh < 2; ++hh) { const f32x4 g = *(const f32x4*)(gamma + col + 4 * hh); f32x4 y;
#pragma unroll
                for (int j = 0; j < 4; ++j) y[j] = v[8 * i + 4 * hh + j] * rstd * g[j];
                *(f32x4*)(out + (size_t)row * D + col + 4 * hh) = y; } }
    }
}

constexpr int LDT = 136;
constexpr int L_X = 0, L_Y1 = 34816, L_Y2 = 69632, L_MISC = 110592;

__device__ __forceinline__ void mm128(const LAS bf16_t* X, const LAS bf16_t* Y, int w, int lr, int quad, f32x4 (&acc)[8]) {
#pragma unroll
    for (int kk = 0; kk < 4; ++kk) {
        const bf16x8 a = *(const LAS bf16x8*)(X + (16 * w + lr) * LDT + kk * 32 + quad * 8);
#pragma unroll
        for (int jt = 0; jt < 8; ++jt) {
            const bf16x8 b = *(const LAS bf16x8*)(Y + (16 * jt + lr) * LDT + kk * 32 + quad * 8);
            acc[jt] = __builtin_amdgcn_mfma_f32_16x16x32_bf16(a, b, acc[jt], 0, 0, 0);
        }
    }
}
__device__ __forceinline__ void mm128T(const LAS bf16_t* X, const LAS bf16_t* Y, int w, int lr, int quad, f32x4 (&acc)[8]) {
#pragma unroll
    for (int kk = 0; kk < 4; ++kk) {
        const bf16x8 a = *(const LAS bf16x8*)(X + (16 * w + lr) * LDT + kk * 32 + quad * 8);
#pragma unroll
        for (int jt = 0; jt < 8; ++jt) {
            const bf16x8 b = *(const LAS bf16x8*)(Y + (16 * jt + lr) * LDT + kk * 32 + quad * 8);
            acc[jt] = __builtin_amdgcn_mfma_f32_16x16x32_bf16(b, a, acc[jt], 0, 0, 0);
        }
    }
}
__device__ __forceinline__ void load_w128(const bf16_t* src, LAS bf16_t* dst) {
    const int tid0 = otid();
#pragma unroll
    for (int i = 0; i < 4; ++i) { const int idx = tid0 + NTHR * i; const int row = idx >> 4, c8 = (idx & 15) * 8;
        *(LAS u32x4*)(dst + row * LDT + c8) = *(const u32x4*)(src + row * 128 + c8); }
}
__device__ __forceinline__ void tile_seq(int slot, int b, int& seqrow0, int& L, int& t0) {
    if (slot < 2) { seqrow0 = MX + b * CTXL; L = CTXL; t0 = slot * 128; } else { seqrow0 = b * SEQ; L = SEQ; t0 = (slot - 2) * 128; }
}

__device__ void lru_tiles(const Params& p, int l, bool final_mode, bool skip_ctx, LAS unsigned char* lds) {
    const int rot = final_mode ? 0 : 24;
    const int tid = otid(), w = tid >> 6, lane = tid & 63, lr = lane & 15, quad = lane >> 4;
    const bf16_t* XIN = (const bf16_t*)(p.ws + WS_Q); bf16_t* YS = (bf16_t*)(p.ws + WS_YS);
    float* AGG = (float*)(p.ws + WS_AGG); unsigned* AB = (unsigned*)(p.ws + WS_AB);
    const bf16_t* sm = (const bf16_t*)(p.ws + WS_SMALL) + (size_t)l * SMALL_L;
    LAS bf16_t* X = (LAS bf16_t*)(lds + L_X);
    LAS float* hst = (LAS float*)(lds + L_MISC);
    const float* convw = p.in[I_CONVW] + (size_t)l * 4 * 512; const float* convb = p.in[I_CONVB] + (size_t)l * 512;
    const int chl = 16 * w + lr;
    const int xb = obid() & 7, xs = obid() >> 3, xn = max((int)gridDim.x >> 3, 1);
    for (int lt = (xs + rot) % xn; lt < 72; lt += xn) {
        const int tile = xb * 72 + lt;
        const int g = tile & 3, slot = (tile >> 2) % 18, b = tile / 72;
        if (skip_ctx && slot < 2) continue;
        int seqrow0, L, t0; tile_seq(slot, b, seqrow0, L, t0);
        const int ch = g * 128 + chl;
        if (!final_mode) {
            const int t = tid >> 2, part = tid & 3;
#pragma unroll
            for (int c8i = 0; c8i < 4; ++c8i) {
                const int c = part * 32 + c8i * 8, chc = g * 128 + c;
                float o[8];
                { const f32x4 b0 = *(const f32x4*)(convb + chc), b1 = *(const f32x4*)(convb + chc + 4);
#pragma unroll
                  for (int j = 0; j < 4; ++j) { o[j] = b0[j]; o[4 + j] = b1[j]; } }
#pragma unroll
                for (int k = 0; k < 4; ++k) {
                    const int tt = t0 + t + k - 2;
                    const bool okk = tt >= 0 && tt < L;
                    const int ttc = okk ? tt : t0 + t;
                    u32x4 zv = *(const u32x4*)(XIN + (size_t)(seqrow0 + ttc) * INW + 1536 + chc);
                    if (!okk) zv = (u32x4){0u, 0u, 0u, 0u};
                    const f32x4 w0 = *(const f32x4*)(convw + k * 512 + chc), w1 = *(const f32x4*)(convw + k * 512 + chc + 4);
                    o[0] += w0[0] * bflo(zv[0]); o[1] += w0[1] * bfhi(zv[0]); o[2] += w0[2] * bflo(zv[1]); o[3] += w0[3] * bfhi(zv[1]);
                    o[4] += w1[0] * bflo(zv[2]); o[5] += w1[1] * bfhi(zv[2]); o[6] += w1[2] * bflo(zv[3]); o[7] += w1[3] * bfhi(zv[3]);
                }
                u32x4 ov; ov[0] = cvt_pk_bf16(o[0], o[1]); ov[1] = cvt_pk_bf16(o[2], o[3]); ov[2] = cvt_pk_bf16(o[4], o[5]); ov[3] = cvt_pk_bf16(o[6], o[7]);
                *(LAS u32x4*)(X + t * LDT + c) = ov;
            }
        }
        if (final_mode && tid < 256) {
            const int dir = tid >> 7, chq = tid & 127;
            const float* ag = AGG + (((size_t)dir * 8 + b) * 18) * 1024 + (g * 128 + chq) * 2;
            float Ag[18], Bg[18];
#pragma unroll
            for (int s2 = 0; s2 < 18; ++s2) { Ag[s2] = ag[s2 * 1024]; Bg[s2] = ag[s2 * 1024 + 1]; }
            float h = 0.f;
            if (dir == 0) {
#pragma unroll
                for (int s2 = 0; s2 < 18; ++s2) if (s2 < slot) h = h * Ag[s2] + Bg[s2];
            } else {
                const int pos = slot == 1 ? 0 : (slot == 0 ? 1 : 19 - slot);
#pragma unroll
                for (int i = 0; i < 18; ++i) { const int s2 = i == 0 ? 1 : (i == 1 ? 0 : 19 - i); if (i < pos) h = h * Ag[s2] + Bg[s2]; }
            }
            hst[dir * 128 + chq] = h;
        }
        __syncthreads();
        f32x4 hsum[8];
#pragma unroll
        for (int rt = 0; rt < 8; ++rt) hsum[rt] = (f32x4){0.f, 0.f, 0.f, 0.f};
        const size_t abrow = (size_t)((seqrow0 + t0 + 4 * quad) >> 2);
        if (!final_mode) {
            bf16x8 bw[4][4];
#pragma unroll
            for (int mt = 0; mt < 4; ++mt) {
                const bf16_t* wp_ = sm + (size_t)(((mt & 1) ? 12 : 4) + (mt >> 1) * 4 + g) * 16384 + chl * 128 + 8 * quad;
#pragma unroll
                for (int kk = 0; kk < 4; ++kk) bw[mt][kk] = *(const bf16x8*)(wp_ + 32 * kk);
            }
            float brg[2], big[2], sp[2];
#pragma unroll
            for (int dir = 0; dir < 2; ++dir) {
                brg[dir] = p.in[I_BRG][(l * 2 + dir) * 512 + ch]; big[dir] = p.in[I_BIG][(l * 2 + dir) * 512 + ch];
                const float lam = p.in[I_LAM][(l * 2 + dir) * 512 + ch];
                sp[dir] = (lam < -15.f) ? -lam : __logf(1.f + __expf(-lam));
            }
            float fA[2][8], fB[2][8];
#pragma unroll
            for (int rt = 0; rt < 8; ++rt) {
                f32x4 acc4[4];
#pragma unroll
                for (int mt = 0; mt < 4; ++mt) acc4[mt] = (f32x4){0.f, 0.f, 0.f, 0.f};
#pragma unroll
                for (int kk = 0; kk < 4; ++kk) {
                    const bf16x8 xa = *(const LAS bf16x8*)(X + (16 * rt + lr) * LDT + kk * 32 + quad * 8);
#pragma unroll
                    for (int mt = 0; mt < 4; ++mt) acc4[mt] = __builtin_amdgcn_mfma_f32_16x16x32_bf16(xa, bw[mt][kk], acc4[mt], 0, 0, 0);
                }
                float z[4];
#pragma unroll
                for (int jj = 0; jj < 4; ++jj) z[jj] = bf2f(X[(16 * rt + 4 * quad + jj) * LDT + chl]);
#pragma unroll
                for (int dir = 0; dir < 2; ++dir) {
                    float ea[4], bv[4]; u32x4 wv;
#pragma unroll
                    for (int jj = 0; jj < 4; ++jj) {
                        const float rr = sigm(acc4[2 * dir][jj] + brg[dir]), ii = sigm(acc4[2 * dir + 1][jj] + big[dir]);
                        const unsigned lab = cvt_pk_bf16(-8.f * rr * sp[dir], 0.f) & 0xffffu;
                        const float la = bflo(lab);
                        const float x2 = 2.f * la, e_ = fexp(la);
                        const float omp = -x2 * (1.f + x2 * (0.5f + x2 * (0.16666667f + x2 * 0.041666668f))), oma = 1.f - e_ * e_;
                        const float om = oma + (omp - oma) * ((x2 > -0.125f) ? 1.f : 0.f);
                        const unsigned pw = cvt_pk_bf16(la, __builtin_amdgcn_sqrtf(om) * (ii * z[jj]));
                        ea[jj] = e_; bv[jj] = bfhi(pw); wv[jj] = pw;
                    }
                    *(u32x4*)(AB + (((size_t)dir * (MT / 4) + abrow + 4 * rt) * 512 + ch) * 4) = wv;
                    float A, Bv;
                    if (dir == 0) { A = ea[0]; Bv = bv[0];
#pragma unroll
                        for (int jj = 1; jj < 4; ++jj) { Bv = Bv * ea[jj] + bv[jj]; A *= ea[jj]; } }
                    else { A = ea[3]; Bv = bv[3];
#pragma unroll
                        for (int jj = 2; jj >= 0; --jj) { Bv = Bv * ea[jj] + bv[jj]; A *= ea[jj]; } }
                    fA[dir][rt] = A; fB[dir][rt] = Bv;
                }
            }
#pragma unroll
            for (int dir = 0; dir < 2; ++dir) {
                float Arun = 1.f, Brun = 0.f;
#pragma unroll
                for (int s1 = 0; s1 < 8; ++s1) {
                    const int rt = dir ? 7 - s1 : s1;
                    float At = 1.f, Bt = 0.f;
#pragma unroll
                    for (int s2 = 0; s2 < 4; ++s2) {
                        const int qq = dir ? 3 - s2 : s2;
                        const float Ao = __shfl(fA[dir][rt], lr + 16 * qq), Bo = __shfl(fB[dir][rt], lr + 16 * qq);
                        Bt = Bt * Ao + Bo; At *= Ao;
                    }
                    Brun = Brun * At + Bt; Arun *= At;
                }
                if (quad == 0) { float* ag = AGG + ((((size_t)dir * 8 + b) * 18 + slot) * 512 + ch) * 2; ag[0] = Arun; ag[1] = Brun; }
            }
        } else {
#pragma unroll 1
        for (int dir = 0; dir < 2; ++dir) {
            const bool rev = dir == 1;
            f32x4 a[8], bb[8];
            {
                u32x4 raw[8];
#pragma unroll
                for (int rt = 0; rt < 8; ++rt) raw[rt] = *(const u32x4*)(AB + (((size_t)dir * (MT / 4) + abrow + 4 * rt) * 512 + ch) * 4);
#pragma unroll
                for (int rt = 0; rt < 8; ++rt)
#pragma unroll
                    for (int jj = 0; jj < 4; ++jj) { a[rt][jj] = fexp(bflo(raw[rt][jj])); bb[rt][jj] = bfhi(raw[rt][jj]); }
            }
            float h = hst[dir * 128 + chl];
#pragma unroll
            for (int s1 = 0; s1 < 8; ++s1) {
                const int rt = rev ? 7 - s1 : s1;
                float A, Bv;
                if (!rev) { A = a[rt][0]; Bv = bb[rt][0];
#pragma unroll
                    for (int jj = 1; jj < 4; ++jj) { Bv = Bv * a[rt][jj] + bb[rt][jj]; A *= a[rt][jj]; } }
                else { A = a[rt][3]; Bv = bb[rt][3];
#pragma unroll
                    for (int jj = 2; jj >= 0; --jj) { Bv = Bv * a[rt][jj] + bb[rt][jj]; A *= a[rt][jj]; } }
                float Ap = 1.f, Bp = 0.f, At = 1.f, Bt = 0.f;
#pragma unroll
                for (int s2 = 0; s2 < 4; ++s2) {
                    const int qq = rev ? 3 - s2 : s2;
                    const float Ao = __shfl(A, lr + 16 * qq), Bo = __shfl(Bv, lr + 16 * qq);
                    const bool before = rev ? (qq > quad) : (qq < quad);
                    if (before) { Bp = Bp * Ao + Bo; Ap *= Ao; }
                    Bt = Bt * Ao + Bo; At *= Ao;
                }
                float hh = h * Ap + Bp;
                if (!rev) {
#pragma unroll
                    for (int jj = 0; jj < 4; ++jj) { hh = a[rt][jj] * hh + bb[rt][jj]; hsum[rt][jj] += hh; } }
                else {
#pragma unroll
                    for (int jj = 3; jj >= 0; --jj) { hh = a[rt][jj] * hh + bb[rt][jj]; hsum[rt][jj] += hh; } }
                h = h * At + Bt;
            }
        }
        }
        if (final_mode) {
#pragma unroll
            for (int rt = 0; rt < 8; ++rt)
#pragma unroll
                for (int jj = 0; jj < 4; ++jj) {
                    const size_t row = (size_t)seqrow0 + t0 + 16 * rt + 4 * quad + jj;
                    const float lg = bf2f(XIN[row * INW + 2048 + ch]);
                    YS[row * D + 1024 + ch] = f2bf(hsum[rt][jj] * gelu_tanh(lg));
                }
        }
        __syncthreads();
    }
}

__device__ void pool_tiles(const Params& p, int l, bool skip_ctx, LAS unsigned char* lds) {
    const int tid = otid(), w = tid >> 6, lane = tid & 63, lr = lane & 15, quad = lane >> 4;
    const bf16_t* XIN = (const bf16_t*)(p.ws + WS_Q); bf16_t* YS = (bf16_t*)(p.ws + WS_YS);
    const bf16_t* sm = (const bf16_t*)(p.ws + WS_SMALL) + (size_t)l * SMALL_L;
    LAS bf16_t* X = (LAS bf16_t*)(lds + L_X); LAS bf16_t* Y1 = (LAS bf16_t*)(lds + L_Y1); LAS bf16_t* ZS = (LAS bf16_t*)(lds + L_Y2);
    const int xb = obid() & 7, xs = obid() >> 3, xn = max((int)gridDim.x >> 3, 1);
    for (int lt = (xs + 24) % xn; lt < 72; lt += xn) {
        const int tile = xb * 72 + lt;
        const int g = tile & 3, slot = (tile >> 2) % 18, b = tile / 72;
        if (skip_ctx && slot < 2) continue;
        int seqrow0, L, t0; tile_seq(slot, b, seqrow0, L, t0);
        const int half = 1 << g;
        load_w128(sm + (size_t)g * 16384, Y1);
        for (int idx = tid; idx < 144 * 16; idx += NTHR) {
            const int rrow = idx >> 4, c8 = (idx & 15) * 8, tt = t0 - 8 + rrow;
            u32x4 v = (u32x4){0u, 0u, 0u, 0u};
            if (tt >= 0 && tt < L) v = *(const u32x4*)(XIN + (size_t)(seqrow0 + tt) * INW + g * 128 + c8);
            *(LAS u32x4*)(ZS + rrow * LDT + c8) = v;
        }
        __syncthreads();
        {
            const int t = tid >> 2, part = tid & 3, tt = t0 + t;
            const int lo = max(tt - half, 0), hi = min(tt + half, L);
            const float inv = 1.f / (float)(hi - lo);
#pragma unroll
            for (int c8i = 0; c8i < 4; ++c8i) {
                const int c = part * 32 + c8i * 8;
                float s[8];
#pragma unroll
                for (int j = 0; j < 8; ++j) s[j] = 0.f;
                for (int q = lo; q < hi; ++q) {
                    const u32x4 v = *(const LAS u32x4*)(ZS + (q - t0 + 8) * LDT + c);
#pragma unroll
                    for (int j = 0; j < 4; ++j) { s[2 * j] += bflo(v[j]); s[2 * j + 1] += bfhi(v[j]); }
                }
                const u32x4 zc = *(const LAS u32x4*)(ZS + (t + 8) * LDT + c);
#pragma unroll
                for (int j = 0; j < 4; ++j) { s[2 * j] = s[2 * j] * inv - bflo(zc[j]); s[2 * j + 1] = s[2 * j + 1] * inv - bfhi(zc[j]); }
                u32x4 ov; ov[0] = cvt_pk_bf16(s[0], s[1]); ov[1] = cvt_pk_bf16(s[2], s[3]); ov[2] = cvt_pk_bf16(s[4], s[5]); ov[3] = cvt_pk_bf16(s[6], s[7]);
                *(LAS u32x4*)(X + t * LDT + c) = ov;
            }
        }
        __syncthreads();
        f32x4 acc[8];
#pragma unroll
        for (int jt = 0; jt < 8; ++jt) acc[jt] = (f32x4){0.f, 0.f, 0.f, 0.f};
        mm128T(X, Y1, w, lr, quad, acc);
        {
            const size_t row = (size_t)seqrow0 + t0 + 16 * w + lr;
#pragma unroll
            for (int jt = 0; jt < 8; ++jt) {
                const int ch = g * 128 + 16 * jt + 4 * quad; const f32x4 ps = *(const f32x4*)(p.in[I_PSCALE] + l * 512 + ch);
                u32x2 o; o[0] = cvt_pk_bf16(acc[jt][0] * ps[0], acc[jt][1] * ps[1]); o[1] = cvt_pk_bf16(acc[jt][2] * ps[2], acc[jt][3] * ps[3]);
                *(u32x2*)(YS + row * D + ch) = o;
            }
        }
        __syncthreads();
    }
}

__device__ void sgu_tiles(const Params& p, int l, bool skip_ctx, LAS unsigned char* lds) {
    const int tid = otid(), w = tid >> 6, lane = tid & 63, lr = lane & 15, quad = lane >> 4;
    const bf16_t* XIN = (const bf16_t*)(p.ws + WS_Q); bf16_t* YS = (bf16_t*)(p.ws + WS_YS);
    const bf16_t* sm = (const bf16_t*)(p.ws + WS_SMALL) + (size_t)l * SMALL_L;
    LAS bf16_t* X = (LAS bf16_t*)(lds + L_X); LAS bf16_t* Y1 = (LAS bf16_t*)(lds + L_Y1);
    const int xb = obid() & 7, xs = obid() >> 3, xn = max((int)gridDim.x >> 3, 1);
    for (int lt = (xs + 16) % xn; lt < 72; lt += xn) {
        const int tile = xb * 72 + lt;
        const int g = tile & 3, slot = (tile >> 2) % 18, b = tile / 72;
        if (skip_ctx && slot < 2) continue;
        int seqrow0, L, t0; tile_seq(slot, b, seqrow0, L, t0);
        load_w128(sm + (size_t)(20 + g) * 16384, X);
        {
            const int t = tid >> 2, part = tid & 3;
            const bf16_t* vrow = XIN + (size_t)(seqrow0 + t0 + t) * INW + 1024;
            float s1 = 0.f, s2 = 0.f;
#pragma unroll
            for (int i = 0; i < 16; ++i) { const u32x4 v = *(const u32x4*)(vrow + part * 128 + i * 8);
#pragma unroll
                for (int j = 0; j < 4; ++j) { const float x0 = bflo(v[j]), x1 = bfhi(v[j]); s1 += x0 + x1; s2 += x0 * x0 + x1 * x1; } }
            s1 += __shfl_xor(s1, 1); s2 += __shfl_xor(s2, 1); s1 += __shfl_xor(s1, 2); s2 += __shfl_xor(s2, 2);
            const float mean = s1 * (1.f / 512.f); const float var = fmaxf(s2 * (1.f / 512.f) - mean * mean, 0.f);
            const float rstd = rsqrtf(var + 1e-6f);
#pragma unroll
            for (int i = 0; i < 4; ++i) {
                const int c = part * 32 + i * 8;
                const u32x4 v = *(const u32x4*)(vrow + g * 128 + c);
                const float* lg = p.in[I_LNG] + l * 512 + g * 128 + c;
#pragma unroll
                for (int j = 0; j < 4; ++j) {
                    Y1[(c + 2 * j) * LDT + t] = f2bf((bflo(v[j]) - mean) * rstd * lg[2 * j]);
                    Y1[(c + 2 * j + 1) * LDT + t] = f2bf((bfhi(v[j]) - mean) * rstd * lg[2 * j + 1]);
                }
            }
        }
        __syncthreads();
        f32x4 acc[8];
#pragma unroll
        for (int jt = 0; jt < 8; ++jt) acc[jt] = (f32x4){0.f, 0.f, 0.f, 0.f};
        mm128T(X, Y1, w, lr, quad, acc);
        {
            const int pp = 16 * w + lr; const float bs = p.in[I_BSP][(l * 4 + g) * 128 + pp];
            const size_t row = (size_t)seqrow0 + t0 + pp;
#pragma unroll
            for (int jt = 0; jt < 8; ++jt) {
                const int ch = g * 128 + 16 * jt + 4 * quad;
                const u32x2 uv = *(const u32x2*)(XIN + row * INW + 512 + ch);
                u32x2 o; o[0] = cvt_pk_bf16(bflo(uv[0]) * (acc[jt][0] + bs), bfhi(uv[0]) * (acc[jt][1] + bs)); o[1] = cvt_pk_bf16(bflo(uv[1]) * (acc[jt][2] + bs), bfhi(uv[1]) * (acc[jt][3] + bs));
                *(u32x2*)(YS + row * D + 512 + ch) = o;
            }
        }
        __syncthreads();
    }
}

constexpr int AK_LD = 136, AV_LD = 72, A_SLOT = 64 * AK_LD * 2 + 128 * AV_LD * 2;
__device__ void attn_tasks(const Params& p, int l, bool with_ctx, LAS unsigned char* lds) {
    const int tid = otid(), w = tid >> 6, lane = tid & 63, lr = lane & 15, quad = lane >> 4;
    const bf16_t* XIN = (const bf16_t*)(p.ws + WS_Q); bf16_t* YS = (bf16_t*)(p.ws + WS_YS);
    const bf16_t* VT = (const bf16_t*)(p.ws + WS_VT); const bf16_t* VTC = (const bf16_t*)(p.ws + WS_VTC);
    const float scale = 0.08838834764831845f;
    const int ntask = 512 + (with_ctx ? 64 : 0);
    LAS float* rpbs = (LAS float*)(lds + L_MISC + 12288);
    for (int i = tid; i < 4 * 465; i += NTHR) rpbs[i] = p.in[I_RPB][(size_t)l * 4 * 465 + i];
    __syncthreads();
    const int krow_t = tid >> 3, kcol_t = (tid & 7) * 16, vrow_t = tid >> 2, vcol_t = (tid & 3) * 16;
    const int xb = obid() & 7, xs = obid() >> 3, xn = max((int)gridDim.x >> 3, 1);
    for (int lt = xs; lt < 64 + (with_ctx ? 8 : 0); lt += xn) {
        const int task = lt < 64 ? xb * 64 + lt : 512 + xb * 8 + (lt - 64);
        const bool isx = task < 512;
        int b, h, r0 = 0, nloc = 0, krow0 = 0, half = 0;
        if (isx) { b = task >> 6; h = (task >> 4) & 3; r0 = (task & 15) * 2; const int rsa = min(max(r0 - 4, 0), 24), rsb = min(max(r0 - 3, 0), 24); krow0 = rsa; nloc = rsb + 8 - rsa; }
        else { const int tc = task - 512; b = tc >> 3; h = (tc >> 1) & 3; half = tc & 1; }
        const int T = nloc + 4;
        const int rq = r0 + (w >> 2), j = w & 3;
        const int qrow0 = isx ? (b * SEQ + rq * 64 + 16 * j) : (MX + b * CTXL + half * 128 + 16 * w);
        const int rs = min(max(rq - 4, 0), 24);
        const int wsc = j == 0 ? 0 : (j == 1 ? 8 : (j == 2 ? 24 : 32));
        const int cq = 16 * j + lr, cs = min(max(cq - 8, 0), 48);
        const LAS float* rpb = rpbs + h * 465;
        bf16x8 qf[4];
#pragma unroll
        for (int kk = 0; kk < 4; ++kk) qf[kk] = *(const bf16x8*)(XIN + (size_t)(qrow0 + lr) * INW + 2560 + h * 128 + 32 * kk + 8 * quad);
        float mx = -3.0e38f, lsum = 0.f;
        f32x4 O[8];
#pragma unroll
        for (int dt = 0; dt < 8; ++dt) O[dt] = (f32x4){0.f, 0.f, 0.f, 0.f};
        u32x4 kr0, kr1, vr0, vr1;
#define ATT_GLOAD(t) do { const bool lt_ = (t) < nloc; \
            const bf16_t* kp_ = XIN + (size_t)(lt_ ? (b * SEQ + (krow0 + (t)) * 64) : (MX + b * CTXL + ((t) - nloc) * 64)) * INW + 3072 + h * 128 + (size_t)krow_t * INW + kcol_t; \
            kr0 = *(const u32x4*)kp_; kr1 = *(const u32x4*)(kp_ + 8); \
            const bf16_t* vp_ = lt_ ? (VT + ((size_t)(b * 4 + h) * 128 + vrow_t) * SEQ + (krow0 + (t)) * 64 + vcol_t) : (VTC + ((size_t)(b * 4 + h) * 128 + vrow_t) * CTXL + ((t) - nloc) * 64 + vcol_t); \
            vr0 = *(const u32x4*)vp_; vr1 = *(const u32x4*)(vp_ + 8); } while (0)
#define ATT_LWRITE(slot) do { LAS bf16_t* Ks_ = (LAS bf16_t*)(lds + (slot) * A_SLOT); LAS bf16_t* Vs_ = Ks_ + 64 * AK_LD; \
            *(LAS u32x4*)(Ks_ + krow_t * AK_LD + kcol_t) = kr0; *(LAS u32x4*)(Ks_ + krow_t * AK_LD + kcol_t + 8) = kr1; \
            *(LAS u32x4*)(Vs_ + vrow_t * AV_LD + vcol_t) = vr0; *(LAS u32x4*)(Vs_ + vrow_t * AV_LD + vcol_t + 8) = vr1; } while (0)
#define ATT_STEP(sv, Vs_, kb) do { float tm_ = sv[0]; _Pragma("unroll") for (int e_ = 1; e_ < 8; ++e_) tm_ = fmaxf(tm_, sv[e_]); \
            tm_ = fmaxf(tm_, __shfl_xor(tm_, 16)); tm_ = fmaxf(tm_, __shfl_xor(tm_, 32)); \
            const float mn_ = fmaxf(mx, tm_); const float al_ = fexp(mx - mn_); mx = mn_; \
            float ps_ = 0.f; _Pragma("unroll") for (int e_ = 0; e_ < 8; ++e_) { sv[e_] = fexp(sv[e_] - mn_); ps_ += sv[e_]; } \
            lsum = lsum * al_ + ps_; \
            if (__builtin_amdgcn_ballot_w64(al_ != 1.f) != 0ull) { _Pragma("unroll") for (int dt_ = 0; dt_ < 8; ++dt_) O[dt_] *= al_; } \
            u32x4 pa_; pa_[0] = cvt_pk_bf16(sv[0], sv[1]); pa_[1] = cvt_pk_bf16(sv[2], sv[3]); pa_[2] = cvt_pk_bf16(sv[4], sv[5]); pa_[3] = cvt_pk_bf16(sv[6], sv[7]); \
            const bf16x8 paf_ = __builtin_bit_cast(bf16x8, pa_); \
            _Pragma("unroll") for (int dt_ = 0; dt_ < 8; ++dt_) { const bf16x8 vv_ = *(const LAS bf16x8*)((Vs_) + (16 * dt_ + lr) * AV_LD + (kb) + 8 * quad); \
                O[dt_] = __builtin_amdgcn_mfma_f32_16x16x32_bf16(vv_, paf_, O[dt_], 0, 0, 0); } } while (0)
        ATT_GLOAD(0); ATT_LWRITE(0);
        ATT_GLOAD(1);
        __syncthreads();
        for (int t = 0; t < T; ++t) {
            const LAS bf16_t* Ks = (const LAS bf16_t*)(lds + (t & 1) * A_SLOT); const LAS bf16_t* Vs = Ks + 64 * AK_LD;
            if (t < nloc) {
                const int kabs = krow0 + t;
                if (kabs >= rs && kabs < rs + 8) {
                    const int drow = kabs - rq + 7;
                    float sv[8];
#pragma unroll
                    for (int hf = 0; hf < 2; ++hf) {
                        const LAS bf16_t* kp = Ks + (wsc + 8 * (lr >> 2) + 4 * hf + (lr & 3)) * AK_LD + 8 * quad;
                        f32x4 a = (f32x4){0.f, 0.f, 0.f, 0.f};
#pragma unroll
                        for (int kk = 0; kk < 4; ++kk) a = __builtin_amdgcn_mfma_f32_16x16x32_bf16(*(const LAS bf16x8*)(kp + 32 * kk), qf[kk], a, 0, 0, 0);
#pragma unroll
                        for (int jj = 0; jj < 4; ++jj) {
                            const int kc = wsc + 8 * quad + 4 * hf + jj;
                            const int dcol = min(max(kc - cq + 15, 0), 30);
                            const bool ok = (kc >= cs) && (kc < cs + 16);
                            const float bv = rpb[drow * 31 + dcol];
                            sv[hf * 4 + jj] = ok ? a[jj] * scale + bv : -1e30f;
                        }
                    }
                    ATT_STEP(sv, Vs, wsc);
                }
            } else {
#pragma unroll
                for (int ks = 0; ks < 2; ++ks) {
                    float sv[8];
#pragma unroll
                    for (int hf = 0; hf < 2; ++hf) {
                        const LAS bf16_t* kp = Ks + (32 * ks + 8 * (lr >> 2) + 4 * hf + (lr & 3)) * AK_LD + 8 * quad;
                        f32x4 a = (f32x4){0.f, 0.f, 0.f, 0.f};
#pragma unroll
                        for (int kk = 0; kk < 4; ++kk) a = __builtin_amdgcn_mfma_f32_16x16x32_bf16(*(const LAS bf16x8*)(kp + 32 * kk), qf[kk], a, 0, 0, 0);
#pragma unroll
                        for (int jj = 0; jj < 4; ++jj) sv[hf * 4 + jj] = a[jj] * scale;
                    }
                    ATT_STEP(sv, Vs, 32 * ks);
                }
            }
            if (t + 1 < T) { ATT_LWRITE((t + 1) & 1); if (t + 2 < T) ATT_GLOAD(t + 2); }
            __syncthreads();
        }
#undef ATT_GLOAD
#undef ATT_LWRITE
#undef ATT_STEP
        lsum += __shfl_xor(lsum, 16); lsum += __shfl_xor(lsum, 32);
        const float linv = 1.f / lsum;
        {
            bf16_t* op = YS + (size_t)(qrow0 + lr) * D + 1536 + h * 128 + 4 * quad;
#pragma unroll
            for (int dt = 0; dt < 8; ++dt) { u32x2 o; o[0] = cvt_pk_bf16(O[dt][0] * linv, O[dt][1] * linv); o[1] = cvt_pk_bf16(O[dt][2] * linv, O[dt][3] * linv); *(u32x2*)(op + 16 * dt) = o; }
        }
    }
}

#define XB_TMO      128
#define XB_XCNT(j)  (256  + 64 * (j))
#define XB_XSUB(j)  (1280 + 64 * (j))
#define XB_XGEN(j)  (2304 + 64 * (j))
#define XB_TOP      3328
#define XB_TOPGEN   3392
#define XCD_BAR_WORDS 3456
#define XB_SPIN_CAP (1u << 18)

__device__ __forceinline__ unsigned xb_ld(unsigned* p)              { return __hip_atomic_load(p, __ATOMIC_RELAXED, __HIP_MEMORY_SCOPE_AGENT); }
__device__ __forceinline__ unsigned xb_add(unsigned* p, unsigned v) { return __hip_atomic_fetch_add(p, v, __ATOMIC_RELAXED, __HIP_MEMORY_SCOPE_AGENT); }
__device__ __forceinline__ unsigned xb_xcc_id() { return (unsigned)__builtin_amdgcn_s_getreg((3 << 11) | 20) & 0xFu; }
#define XB_SPIN(cond, bar) do { unsigned _sp = 0; while (cond) { __builtin_amdgcn_s_sleep(1); \
    if ((++_sp & 255u) == 0u) { if (xb_ld(&(bar)[XB_TMO])) break; if (_sp > XB_SPIN_CAP) { atomicAdd(&(bar)[XB_TMO], 1u); break; } } } } while (0)

struct XcdBarrier {
    unsigned* bar; unsigned x;
    volatile LAS unsigned* st;
};

__device__ __forceinline__ XcdBarrier xcd_barrier_post(unsigned* bar, volatile LAS unsigned* st) {
    XcdBarrier b; b.bar = bar; b.x = xb_xcc_id(); b.st = st;
    if (threadIdx.x == 0) (void)xb_add(&bar[XB_XCNT(b.x)], 1u);
    return b;
}
__device__ __forceinline__ void xcd_barrier_complete(unsigned* bar, unsigned x, unsigned& nloc, unsigned& nx) {
    const unsigned G = gridDim.x * gridDim.y * gridDim.z;
    unsigned sum, cnt, mine, sp = 0u;
    for (;;) {
        sum = 0u; cnt = 0u; mine = 0u;
#pragma unroll
        for (unsigned j = 0; j < 16; ++j) { const unsigned c = xb_ld(&bar[XB_XCNT(j)]); sum += c; cnt += (c > 0u) ? 1u : 0u; mine = (j == x) ? c : mine; }
        if (sum == G) break;
        __builtin_amdgcn_s_sleep(1);
        if ((++sp & 255u) == 0u) { if (xb_ld(&bar[XB_TMO])) break; if (sp > XB_SPIN_CAP) { atomicAdd(&bar[XB_TMO], 1u); break; } }
    }
    nloc = mine > 0u ? mine : 1u; nx = cnt > 0u ? cnt : 1u;
}

__device__ __forceinline__ void xcd_barrier(const XcdBarrier& b) {
    asm volatile("s_waitcnt vmcnt(0)" ::: "memory");
    __syncthreads();
    if (threadIdx.x == 0) {
        unsigned* bar = b.bar;
        __builtin_amdgcn_s_waitcnt(0);
        unsigned nloc = b.st[0], nx = b.st[1];
        if (nloc == 0u) { xcd_barrier_complete(bar, b.x, nloc, nx); b.st[0] = nloc; b.st[1] = nx; }
        const unsigned old = xb_add(&bar[XB_XSUB(b.x)], 1u);
        const unsigned gen = old / nloc;
        if (old + 1u == (gen + 1u) * nloc) {
            __builtin_amdgcn_fence(__ATOMIC_RELEASE, "agent");
            asm volatile("s_waitcnt vmcnt(0)" ::: "memory");
            const unsigned og = xb_add(&bar[XB_TOP], 1u);
            const unsigned tg = og / nx;
            if (og + 1u == (tg + 1u) * nx) xb_add(&bar[XB_TOPGEN], 1u);
            else XB_SPIN(xb_ld(&bar[XB_TOPGEN]) == tg, bar);
            __builtin_amdgcn_fence(__ATOMIC_ACQUIRE, "agent");
            xb_add(&bar[XB_XGEN(b.x)], 1u);
            asm volatile("s_waitcnt vmcnt(0)" ::: "memory");
        } else {
            XB_SPIN(xb_ld(&bar[XB_XGEN(b.x)]) == gen, bar);
            __builtin_amdgcn_fence(__ATOMIC_ACQUIRE, "agent");
            asm volatile("s_waitcnt vmcnt(0)" ::: "memory");
        }
    }
    __syncthreads();
}


typedef const __attribute__((address_space(4))) Params* KPtr;
__device__ __forceinline__ Params kparams() {
#if defined(__HIP_DEVICE_COMPILE__)
    KPtr q = (KPtr)__builtin_amdgcn_kernarg_segment_ptr(); asm volatile("" : "+s"(q)); return *q;
#else
    return Params{};
#endif
}
#define PP kparams()
__global__ void __launch_bounds__(NTHR, 2) fwd_mega(Params p_unused) {
    extern __shared__ __attribute__((aligned(16))) unsigned char smem[];
    LAS unsigned char* lds = (LAS unsigned char*)smem;
    cg::grid_group grid = cg::this_grid();
    unsigned char* ws = kparams().ws;
    volatile LAS unsigned* bst = (volatile LAS unsigned*)(lds + LDS_BYTES - 16);
    if (threadIdx.x == 0) { bst[0] = 0u; bst[1] = 0u; }
    __syncthreads();
    const XcdBarrier xbar = xcd_barrier_post((unsigned*)(ws + WS_BAR), bst);
#define GSYNC() xcd_barrier(xbar)
    bf16_t* XR = (bf16_t*)(ws + WS_XR); bf16_t* H = (bf16_t*)(ws + WS_H); bf16_t* Q = (bf16_t*)(ws + WS_Q); bf16_t* YS = (bf16_t*)(ws + WS_YS);
    const float* mod = (const float*)(ws + WS_MOD);

    phase_mod(PP, (LAS float*)lds);
    convert_layer(PP, 0, (LAS float*)lds);
    grid.sync();

#pragma unroll 1
    for (int l = 0; l < 2; ++l) {
        const bool last = l == 1;
        const float* modl = mod + (size_t)l * 9 * 12288;
        const int Mrows = last ? MX : MT;
        if (l == 0) phase_norm<true>(PP.in[I_X], PP.in[I_CTX], nullptr, PP.in[I_GMIX], modl, 0, 1, H, MT);
        else { phase_norm<false>(nullptr, nullptr, XR, PP.in[I_GMIX] + D, modl, 0, 1, H, MT); convert_layer(PP, 1, (LAS float*)lds); }
        GSYNC();
        { pg8::Gemm g{H, (const bf16_t*)(ws + WS_WIN), D, 0, MT, INW, D, 8};
          pg8::EpiStore E{Q, INW, 14, (bf16_t*)(ws + WS_VT), (bf16_t*)(ws + WS_VTC)};
          pg8::gemm_phase(lds, g, E); }
        GSYNC();
        attn_tasks(PP, l, !last, lds);
        lru_tiles(PP, l, false, false, lds);
        GSYNC();
        lru_tiles(PP, l, true, last, lds);
        pool_tiles(PP, l, last, lds);
        sgu_tiles(PP, l, last, lds);
        GSYNC();
        { pg8::Gemm g{YS, (const bf16_t*)(ws + WS_WB), D, 1024, Mrows, 8192, 512, 8};
          pg8::EpiStore E{Q, 8192, 1 << 30, nullptr, nullptr};
          pg8::gemm_phase(lds, g, E); }
        GSYNC();
        { pg8::Gemm g{H, (const bf16_t*)(ws + WS_GATE), D, 0, Mrows, 8192, D, 8};
          pg8::EpiGate E{Q, YS};
          pg8::gemm_phase(lds, g, E); }
        GSYNC();
        { pg8::Gemm g{YS, (const bf16_t*)(ws + WS_WO), D, 0, Mrows, D, D, 4};
          pg8::EpiRes E{XR, modl + 2 * 2048, l == 0 ? PP.in[I_X] : nullptr, PP.in[I_CTX]};
          pg8::gemm_phase(lds, g, E); }
        GSYNC();
        phase_norm<false>(nullptr, nullptr, XR, PP.in[I_GFFN] + (size_t)l * D, modl, 3, 4, H, Mrows);
        GSYNC();
        { pg8::Gemm g{H, (const bf16_t*)(ws + WS_GU), D, 0, Mrows, 2 * DFF, D, 8};
          pg8::EpiSwi E{Q};
          pg8::gemm_phase(lds, g, E); }
        GSYNC();
        { pg8::Gemm g{Q, (const bf16_t*)(ws + WS_WD), DFF, 0, Mrows, D, DFF, 4};
          pg8::EpiRes E{XR, modl + 5 * 2048, nullptr, nullptr};
          pg8::gemm_phase(lds, g, E); }
        GSYNC();
    }
    phase_final(XR, PP.in[I_GFINAL], PP.out);
}

extern "C" void kernel_launch(void* const* d_in, const int* in_sizes, int n_in, void* d_out, int out_size, void* d_ws, size_t ws_size, hipStream_t stream) {
    static int grid = 0;
    if (grid == 0) {
        if (n_in != 29 || ws_size < WS_END) { fprintf(stderr, "kernel_launch: n_in %d ws %zu need %zu\n", n_in, ws_size, (size_t)WS_END); grid = -1; return; }
        int dev = 0, cus = 0, per_cu = 0;
        hipGetDevice(&dev);
        hipDeviceGetAttribute(&cus, hipDeviceAttributeMultiprocessorCount, dev);
        hipFuncSetAttribute((const void*)fwd_mega, hipFuncAttributeMaxDynamicSharedMemorySize, LDS_BYTES);
        hipOccupancyMaxActiveBlocksPerMultiprocessor(&per_cu, (const void*)fwd_mega, NTHR, LDS_BYTES);
        if (per_cu < 1) { fprintf(stderr, "kernel_launch: occupancy query says %d blocks/CU\n", per_cu); per_cu = 1; }
        grid = cus * 1;
        (void)hipGetLastError();
    }
    if (grid < 0) return;
    Params p{};
    for (int i = 0; i < 29; ++i) p.in[i] = (const float*)d_in[i];
    p.out = (float*)d_out; p.ws = (unsigned char*)d_ws;
    (void)hipMemsetAsync((unsigned char*)d_ws + WS_BAR, 0, 3456 * 4, stream);
    void* args[] = {&p};
    hipError_t e = hipLaunchCooperativeKernel((const void*)fwd_mega, dim3(grid), dim3(NTHR), args, LDS_BYTES, stream);
    if (e != hipSuccess) fprintf(stderr, "cooperative launch failed: %s (grid %d)\n", hipGetErrorString(e), grid);
}
```

```cpp
#include <hip/hip_runtime.h>
#include <hip/hip_cooperative_groups.h>
#include <cstdio>
#include <cstdint>
namespace cg = cooperative_groups;

#define LAS __attribute__((address_space(3)))
typedef unsigned short bf16_t;
typedef short bf16x8 __attribute__((ext_vector_type(8)));
typedef float f32x4 __attribute__((ext_vector_type(4)));
typedef unsigned u32x4 __attribute__((ext_vector_type(4)));
typedef unsigned u32x2 __attribute__((ext_vector_type(2)));

constexpr int D = 2048, NB = 8, SEQ = 2048, CTXL = 256;
constexpr int MX = NB * SEQ, MC = NB * CTXL, MT = MX + MC;
constexpr int INW = 4096, DFF = 5632;
constexpr int NTHR = 512;
constexpr int LDS_BYTES = 147456;

constexpr size_t al256(size_t x) { return (x + 255) & ~(size_t)255; }
constexpr size_t WS_MOD   = 0;
constexpr size_t WS_AGG   = al256(WS_MOD + (size_t)2 * 9 * 12288 * 4);
constexpr size_t WS_SMALL = al256(WS_AGG + (size_t)2 * 8 * 18 * 512 * 2 * 4);
constexpr size_t SMALL_L  = (size_t)24 * 16384;
constexpr size_t WS_WIN   = al256(WS_SMALL + 2 * SMALL_L * 2);
constexpr size_t WS_GATE  = al256(WS_WIN + (size_t)4096 * 2048 * 2);
constexpr size_t WS_WB    = al256(WS_GATE + (size_t)8192 * 2048 * 2);
constexpr size_t WS_WO    = al256(WS_WB + (size_t)8192 * 512 * 2);
constexpr size_t WS_GU    = al256(WS_WO + (size_t)2048 * 2048 * 2);
constexpr size_t WS_WD    = al256(WS_GU + (size_t)11264 * 2048 * 2);
constexpr size_t WS_XR    = al256(WS_WD + (size_t)2048 * 5632 * 2);
constexpr size_t WS_H     = al256(WS_XR + (size_t)MT * D * 2);
constexpr size_t WS_Q     = al256(WS_H + (size_t)MT * D * 2);
constexpr size_t WS_YS    = al256(WS_Q + (size_t)MT * 8192 * 2);
constexpr size_t WS_VT    = al256(WS_YS + (size_t)MT * D * 2);
constexpr size_t WS_VTC   = al256(WS_VT + (size_t)NB * 4 * 128 * SEQ * 2);
constexpr size_t WS_AB    = al256(WS_VTC + (size_t)NB * 4 * 128 * CTXL * 2);
constexpr size_t WS_BAR   = al256(WS_AB + (size_t)MT * 2 * 512 * 4);
constexpr size_t WS_END   = al256(WS_BAR + 3456 * 4);

struct Params { const float* in[29]; float* out; unsigned char* ws; };
enum { I_X = 0, I_C, I_CTX, I_CCTX, I_WMOD, I_BMOD, I_GMIX, I_GFFN, I_GFINAL, I_WIN, I_WPOOL, I_PSCALE, I_LNG, I_WSP, I_BSP, I_CONVW, I_CONVB,
       I_WRG, I_BRG, I_WIG, I_BIG, I_LAM, I_RPB, I_WBR, I_WGATE, I_WOUT, I_WFG, I_WFU, I_WFD };

__device__ __forceinline__ unsigned cvt_pk_bf16(float lo, float hi) { unsigned r; asm volatile("v_cvt_pk_bf16_f32 %0, %1, %2" : "=v"(r) : "v"(lo), "v"(hi)); return r; }
__device__ __forceinline__ bf16_t f2bf(float f) { return (bf16_t)(cvt_pk_bf16(f, 0.f) & 0xffffu); }
__device__ __forceinline__ float bf2f(bf16_t b) { return __uint_as_float(((unsigned)b) << 16); }
__device__ __forceinline__ float bflo(unsigned u) { return __uint_as_float(u << 16); }
__device__ __forceinline__ float bfhi(unsigned u) { return __uint_as_float(u & 0xffff0000u); }
__device__ __forceinline__ float sigm(float x) { return __builtin_amdgcn_rcpf(1.f + __builtin_amdgcn_exp2f(-1.4426950408889634f * x)); }
__device__ __forceinline__ float fexp(float x) { return __builtin_amdgcn_exp2f(1.4426950408889634f * x); }
__device__ __forceinline__ float gelu_tanh(float x) { const float u = 0.7978845608028654f * (x + 0.044715f * x * x * x); return x * sigm(2.f * u); }
__device__ __forceinline__ int otid() { int t = threadIdx.x; asm volatile("" : "+v"(t)); return t; }
__device__ __forceinline__ int obid() { int t = blockIdx.x; asm volatile("" : "+s"(t)); return t; }
__device__ __forceinline__ float wave_sum(float v) {
#pragma unroll
    for (int o = 32; o >= 1; o >>= 1) v += __shfl_xor(v, o);
    return v;
}

namespace pg8 {
constexpr int BM = 256, BK = 64, HALF = 128, HTB = HALF * BK * 2, STAGE_BYTES = 8 * HTB, NXCD = 8, WGM = 8;
__device__ __forceinline__ int lds_byte(int r, int c) { const int st = (r >> 4) * 2 + (c >> 5), rr = r & 15, cc = c & 31, ob = rr * 64 + cc * 2; return st * 1024 + (ob ^ (((ob >> 9) & 1) << 5)); }
__device__ __forceinline__ void stage_rc(int b, int& R, int& C) { const int st = b / 1024, sb = b % 1024, swz = sb ^ (((sb >> 9) & 1) << 5); R = (st >> 1) * 16 + swz / 64; C = (st & 1) * 32 + (swz % 64) / 2; }
__device__ __forceinline__ int perm32(int rho) { const int n = rho >> 4, i = rho & 15; return 8 * (i >> 2) + 4 * n + (i & 3); }

struct Unit { int pm, pn; };
struct Gemm { const bf16_t* A; const bf16_t* Bt; int lda; int a_grp_bytes; int M, N, K; int wgm; };

struct StaticOrder {
    int nM, nN, nwg, G, c, wgm;
    __device__ void init(int M, int N, int G_, int c_, int w_) { nM = M / BM; nN = N / BM; nwg = nM * nN; G = G_; c = c_; wgm = w_; }
    __device__ bool next(int i, Unit& u) const {
        const long L = (long)i * G + c; if (L >= nwg) return false;
        int wgid = (int)L; { const int q = nwg / NXCD, r = nwg % NXCD, xcd = wgid % NXCD, off = wgid / NXCD; wgid = (xcd < r ? xcd * (q + 1) : r * (q + 1) + (xcd - r) * q) + off; }
        const int nig = wgm * nN, gid = wgid / nig, fm = gid * wgm, gsz = (nM - fm) < wgm ? (nM - fm) : wgm;
        u.pm = fm + ((wgid % nig) % gsz); u.pn = (wgid % nig) / gsz; return true;
    }
};


struct EpiStore {
    static constexpr bool PERM = true;
    bf16_t* O; int ldc; int vt_pn; bf16_t* VT; bf16_t* VTC;
    __device__ __forceinline__ void operator()(const f32x4 (&acc)[2][2][4][2], const Unit& u, int wr, int wc, int fr, int fq) const {
        if (u.pn < vt_pn) {
            const int row0 = u.pm * BM + wr * 64 + fr, col0 = u.pn * BM + wc * 32 + 8 * fq;
#pragma unroll
            for (int ai = 0; ai < 2; ++ai)
#pragma unroll
                for (int m = 0; m < 4; ++m) { bf16_t* rowp = O + (size_t)(row0 + ai * HALF + m * 16) * ldc + col0;
#pragma unroll
                    for (int bj = 0; bj < 2; ++bj) { const f32x4 v0 = acc[ai][bj][m][0], v1 = acc[ai][bj][m][1];
                        u32x4 o; o[0] = cvt_pk_bf16(v0[0], v0[1]); o[1] = cvt_pk_bf16(v0[2], v0[3]); o[2] = cvt_pk_bf16(v1[0], v1[1]); o[3] = cvt_pk_bf16(v1[2], v1[3]);
                        *(u32x4*)(rowp + bj * HALF) = o; } }
        } else {
            const bool isx = u.pm < 64;
            const int b = isx ? (u.pm >> 3) : (u.pm - 64);
            const int tb = isx ? (u.pm & 7) * 256 : 0;
            const int tlen = isx ? SEQ : CTXL;
            bf16_t* base = isx ? VT : VTC;
#pragma unroll
            for (int bj = 0; bj < 2; ++bj)
#pragma unroll
                for (int n = 0; n < 2; ++n)
#pragma unroll
                    for (int j = 0; j < 4; ++j) {
                        const int hd = (u.pn - vt_pn) * BM + bj * HALF + wc * 32 + 8 * fq + 4 * n + j;
                        bf16_t* colp = base + ((size_t)b * 512 + hd) * tlen + tb + wr * 64 + fr;
#pragma unroll
                        for (int ai = 0; ai < 2; ++ai)
#pragma unroll
                            for (int m = 0; m < 4; ++m) colp[ai * HALF + m * 16] = f2bf(acc[ai][bj][m][n][j]);
                    }
        }
    }
};
struct EpiGate {
    static constexpr bool PERM = false;
    const bf16_t* P; bf16_t* O;
    __device__ __forceinline__ void operator()(const f32x4 (&acc)[2][2][4][2], const Unit& u, int wr, int wc, int fr, int fq) const {
        const int row0 = u.pm * BM + wr * 64 + fr, col = u.pn * 64 + wc * 16 + 4 * fq;
        const bf16_t* pb = P + (size_t)row0 * 8192 + col;
        u32x2 pv[2][4][4];
#pragma unroll
        for (int ai = 0; ai < 2; ++ai)
#pragma unroll
            for (int m = 0; m < 4; ++m)
#pragma unroll
                for (int br = 0; br < 4; ++br) pv[ai][m][br] = *(const u32x2*)(pb + (size_t)(ai * HALF + m * 16) * 8192 + br * 2048);
        __builtin_amdgcn_sched_barrier(0);
        f32x4 sg[2][2][4][2];
#pragma unroll
        for (int ai = 0; ai < 2; ++ai)
#pragma unroll
            for (int bj = 0; bj < 2; ++bj)
#pragma unroll
                for (int m = 0; m < 4; ++m)
#pragma unroll
                    for (int n = 0; n < 2; ++n) { const f32x4 a = acc[ai][bj][m][n]; f32x4 r; r[0] = sigm(a[0]); r[1] = sigm(a[1]); r[2] = sigm(a[2]); r[3] = sigm(a[3]); sg[ai][bj][m][n] = r; }
        __builtin_amdgcn_sched_barrier(0);
#pragma unroll
        for (int ai = 0; ai < 2; ++ai)
#pragma unroll
            for (int m = 0; m < 4; ++m) {
                const size_t row = (size_t)(row0 + ai * HALF + m * 16);
                float s0 = 0.f, s1 = 0.f, s2 = 0.f, s3 = 0.f;
#pragma unroll
                for (int bj = 0; bj < 2; ++bj)
#pragma unroll
                    for (int n = 0; n < 2; ++n) {
                        const u32x2 pq = pv[ai][m][bj * 2 + n];
                        const f32x4 a = sg[ai][bj][m][n];
                        s0 += a[0] * bflo(pq[0]); s1 += a[1] * bfhi(pq[0]); s2 += a[2] * bflo(pq[1]); s3 += a[3] * bfhi(pq[1]);
                    }
                u32x2 o; o[0] = cvt_pk_bf16(s0, s1); o[1] = cvt_pk_bf16(s2, s3);
                *(u32x2*)(O + row * 2048 + col) = o;
            }
    }
};
struct EpiRes {
    static constexpr bool PERM = true;
    bf16_t* XR; const float* gate; const float* srcx; const float* srcc;
    __device__ __forceinline__ void operator()(const f32x4 (&acc)[2][2][4][2], const Unit& u, int wr, int wc, int fr, int fq) const {
        const int brow = u.pm < 64 ? (u.pm >> 3) : 8;
        const int row0 = u.pm * BM + wr * 64 + fr, col0 = u.pn * BM + wc * 32 + 8 * fq;
        const float* gp = gate + (size_t)brow * 12288 + col0;
        f32x4 gv[2][2];
#pragma unroll
        for (int bj = 0; bj < 2; ++bj)
#pragma unroll
            for (int n = 0; n < 2; ++n) gv[bj][n] = *(const f32x4*)(gp + bj * HALF + n * 4);
        if (srcx) {
            const float* sb = u.pm < 64 ? srcx + (size_t)row0 * D : srcc + (size_t)(row0 - MX) * D;
#pragma unroll
            for (int ai = 0; ai < 2; ++ai)
#pragma unroll
                for (int m = 0; m < 4; ++m) { const size_t ro = (size_t)(ai * HALF + m * 16) * D + col0;
#pragma unroll
                    for (int bj = 0; bj < 2; ++bj) {
                        const f32x4 x0 = *(const f32x4*)(sb + ro + bj * HALF), x1 = *(const f32x4*)(sb + ro + bj * HALF + 4);
                        const f32x4 y0 = x0 + gv[bj][0] * acc[ai][bj][m][0], y1 = x1 + gv[bj][1] * acc[ai][bj][m][1];
                        u32x4 o; o[0] = cvt_pk_bf16(y0[0], y0[1]); o[1] = cvt_pk_bf16(y0[2], y0[3]); o[2] = cvt_pk_bf16(y1[0], y1[1]); o[3] = cvt_pk_bf16(y1[2], y1[3]);
                        *(u32x4*)(XR + (size_t)row0 * D + ro + bj * HALF) = o; } }
        } else {
            bf16_t* xb = XR + (size_t)row0 * D + col0;
            u32x4 xv[2][4][2];
#pragma unroll
            for (int ai = 0; ai < 2; ++ai)
#pragma unroll
                for (int m = 0; m < 4; ++m)
#pragma unroll
                    for (int bj = 0; bj < 2; ++bj) xv[ai][m][bj] = *(const u32x4*)(xb + (size_t)(ai * HALF + m * 16) * D + bj * HALF);
            __builtin_amdgcn_sched_barrier(0);
#pragma unroll
            for (int ai = 0; ai < 2; ++ai)
#pragma unroll
                for (int m = 0; m < 4; ++m)
#pragma unroll
                    for (int bj = 0; bj < 2; ++bj) {
                        const u32x4 x = xv[ai][m][bj]; const f32x4 a0 = acc[ai][bj][m][0], a1 = acc[ai][bj][m][1]; const f32x4 g0 = gv[bj][0], g1 = gv[bj][1];
                        u32x4 o;
                        o[0] = cvt_pk_bf16(bflo(x[0]) + g0[0] * a0[0], bfhi(x[0]) + g0[1] * a0[1]); o[1] = cvt_pk_bf16(bflo(x[1]) + g0[2] * a0[2], bfhi(x[1]) + g0[3] * a0[3]);
                        o[2] = cvt_pk_bf16(bflo(x[2]) + g1[0] * a1[0], bfhi(x[2]) + g1[1] * a1[1]); o[3] = cvt_pk_bf16(bflo(x[3]) + g1[2] * a1[2], bfhi(x[3]) + g1[3] * a1[3]);
                        *(u32x4*)(xb + (size_t)(ai * HALF + m * 16) * D + bj * HALF) = o;
                    }
        }
    }
};
struct EpiSwi {
    static constexpr bool PERM = true;
    bf16_t* O;
    __device__ __forceinline__ void operator()(const f32x4 (&acc)[2][2][4][2], const Unit& u, int wr, int wc, int fr, int fq) const {
        const int row0 = u.pm * BM + wr * 64 + fr, col0 = u.pn * HALF + wc * 32 + 8 * fq;
#pragma unroll
        for (int ai = 0; ai < 2; ++ai)
#pragma unroll
            for (int m = 0; m < 4; ++m) {
                float v[8];
#pragma unroll
                for (int n = 0; n < 2; ++n)
#pragma unroll
                    for (int j = 0; j < 4; ++j) { const float g = acc[ai][0][m][n][j], uu = acc[ai][1][m][n][j]; v[n * 4 + j] = g * sigm(g) * uu; }
                u32x4 o; o[0] = cvt_pk_bf16(v[0], v[1]); o[1] = cvt_pk_bf16(v[2], v[3]); o[2] = cvt_pk_bf16(v[4], v[5]); o[3] = cvt_pk_bf16(v[6], v[7]);
                *(u32x4*)(O + (size_t)(row0 + ai * HALF + m * 16) * DFF + col0) = o;
            }
    }
};

template <class Epi>
__device__ __forceinline__ void gemm_phase(LAS unsigned char* lds, const Gemm g, const Epi& E) {
    const int tid = otid(), wid = __builtin_amdgcn_readfirstlane(tid >> 6), lane = tid & 63, wr = wid >> 2, wc = wid & 3, fr = lane & 15, fq = lane >> 4;
    const int K = g.K, nt = K / BK;
    StaticOrder S; S.init(g.M, g.N, gridDim.x, obid(), g.wgm);
    unsigned voffA[2], voffB[2];
#pragma unroll
    for (int i = 0; i < 2; ++i) { int R, C; stage_rc(tid * 16 + i * 8192, R, C); const int Rb = Epi::PERM ? ((R & ~31) + perm32(R & 31)) : R;
        voffA[i] = (unsigned)(R * g.lda + C) * 2u; voffB[i] = (unsigned)(Rb * K + C) * 2u; }
    const size_t kstep = (size_t)(BK * 2);
    const size_t hstepA = (size_t)HALF * g.lda * 2, tstepA = 2 * hstepA;
    const size_t hstepB = (size_t)HALF * K * 2, tstepB = 2 * hstepB;
    const unsigned ldsw = (unsigned)wid * 1024u;
    const int aoff = lds_byte(wr * 64 + fr, fq * 8), boff = lds_byte(wc * 32 + fr, fq * 8);
#define PG8_SA(b, h) (((b) * 2 + (h)) * HTB)
#define PG8_SB(b, h) ((4 + (b) * 2 + (h)) * HTB)
#define PG8_STAGE(bufoff, gbase, voff) do { _Pragma("unroll") for (int _i = 0; _i < 2; ++_i) \
        __builtin_amdgcn_global_load_lds((const unsigned*)((const char*)(gbase) + (voff)[_i]), (LAS unsigned*)(lds + (bufoff) + ldsw + _i * 8192), 16, 0, 0); } while (0)
#define PG8_LDA(dst, b, h) do { _Pragma("unroll") for (int m = 0; m < 4; ++m) _Pragma("unroll") for (int k = 0; k < 2; ++k) dst[m][k] = *(const LAS bf16x8*)(lds + PG8_SA(b, h) + aoff + m * 2048 + k * 1024); } while (0)
#define PG8_LDB(dst, b, h) do { _Pragma("unroll") for (int n = 0; n < 2; ++n) _Pragma("unroll") for (int k = 0; k < 2; ++k) dst[n][k] = *(const LAS bf16x8*)(lds + PG8_SB(b, h) + boff + n * 2048 + k * 1024); } while (0)
#define PG8_MMA(ai, bj, At, Bt) do { __builtin_amdgcn_s_setprio(1); _Pragma("unroll") for (int m = 0; m < 4; ++m) _Pragma("unroll") for (int n = 0; n < 2; ++n) _Pragma("unroll") for (int k = 0; k < 2; ++k) \
        acc[ai][bj][m][n] = __builtin_amdgcn_mfma_f32_16x16x32_bf16(Bt[n][k], At[m][k], acc[ai][bj][m][n], 0, 0, 0); __builtin_amdgcn_s_setprio(0); } while (0)
#define PG8_WAIT_V(n) asm volatile("s_waitcnt vmcnt(" #n ")" ::: "memory")
#define PG8_WAIT_L(n) asm volatile("s_waitcnt lgkmcnt(" #n ")" ::: "memory")
#define PG8_BAR __builtin_amdgcn_s_barrier()
#define PG8_SCHED __builtin_amdgcn_sched_barrier(0)
    Unit cur, nxt; int ui = 0;
    if (!S.next(0, cur)) return;
    f32x4 acc[2][2][4][2];
#pragma unroll
    for (int a = 0; a < 2; ++a)
#pragma unroll
        for (int b = 0; b < 2; ++b)
#pragma unroll
            for (int m = 0; m < 4; ++m)
#pragma unroll
                for (int n = 0; n < 2; ++n) acc[a][b][m][n] = (f32x4){0.f, 0.f, 0.f, 0.f};
    bf16x8 At[4][2], B0[2][2], B1[2][2];
    const char* cA = (const char*)g.A + (size_t)cur.pm * tstepA + (size_t)(cur.pn >> 3) * g.a_grp_bytes; const char* cB = (const char*)g.Bt + (size_t)cur.pn * tstepB;
    PG8_STAGE(PG8_SB(0, 0), cB, voffB); PG8_STAGE(PG8_SB(0, 1), cB + hstepB, voffB); PG8_STAGE(PG8_SA(0, 0), cA, voffA); PG8_STAGE(PG8_SA(0, 1), cA + hstepA, voffA);
    if (wr == 1) PG8_BAR;
    PG8_WAIT_V(2); PG8_BAR;
    PG8_STAGE(PG8_SB(1, 0), cB + kstep, voffB); PG8_STAGE(PG8_SA(1, 0), cA + kstep, voffA); PG8_STAGE(PG8_SB(1, 1), cB + hstepB + kstep, voffB);
    PG8_WAIT_V(6); PG8_BAR;
    for (;;) {
        const bool has_next = S.next(ui + 1, nxt);
        const char* nA = has_next ? (const char*)g.A + (size_t)nxt.pm * tstepA + (size_t)(nxt.pn >> 3) * g.a_grp_bytes : cA; const char* nB = has_next ? (const char*)g.Bt + (size_t)nxt.pn * tstepB : cB;
        for (int t = 0; t < nt; t += 2) {
            const bool last = (t == nt - 2);
            const char* a1 = cA + (size_t)(t + 1) * kstep;
            const char* a2 = last ? nA : cA + (size_t)(t + 2) * kstep; const char* b2 = last ? nB : cB + (size_t)(t + 2) * kstep;
            const char* a3 = a2 + kstep; const char* b3 = b2 + kstep;
            PG8_LDB(B0, 0, 0); PG8_LDB(B1, 0, 1); PG8_SCHED; PG8_LDA(At, 0, 0); PG8_STAGE(PG8_SA(1, 1), a1 + hstepA, voffA);
            PG8_WAIT_V(8); PG8_WAIT_L(0); PG8_BAR; PG8_MMA(0, 0, At, B0); PG8_MMA(0, 1, At, B1); PG8_BAR; PG8_SCHED;
            PG8_LDA(At, 0, 1); PG8_STAGE(PG8_SB(0, 0), b2, voffB); PG8_STAGE(PG8_SB(0, 1), b2 + hstepB, voffB); PG8_STAGE(PG8_SA(0, 0), a2, voffA);
            PG8_WAIT_V(8); PG8_WAIT_L(0); PG8_BAR; PG8_MMA(1, 0, At, B0); PG8_MMA(1, 1, At, B1); PG8_BAR; PG8_SCHED;
            PG8_LDB(B0, 1, 0); PG8_LDB(B1, 1, 1); PG8_SCHED; PG8_LDA(At, 1, 0); PG8_STAGE(PG8_SA(0, 1), a2 + hstepA, voffA);
            PG8_WAIT_V(8); PG8_WAIT_L(0); PG8_BAR; PG8_MMA(0, 0, At, B0); PG8_MMA(0, 1, At, B1); PG8_BAR; PG8_SCHED;
            PG8_LDA(At, 1, 1); PG8_STAGE(PG8_SB(1, 0), b3, voffB); PG8_STAGE(PG8_SB(1, 1), b3 + hstepB, voffB); PG8_STAGE(PG8_SA(1, 0), a3, voffA);
            PG8_WAIT_V(8); PG8_WAIT_L(0); PG8_BAR; PG8_MMA(1, 0, At, B0); PG8_MMA(1, 1, At, B1); PG8_BAR; PG8_SCHED;
        }
        if (wr == 0) PG8_BAR;
        E(acc, cur, wr, wc, fr, fq);
        if (!has_next) break;
#pragma unroll
        for (int a = 0; a < 2; ++a)
#pragma unroll
            for (int b = 0; b < 2; ++b)
#pragma unroll
                for (int m = 0; m < 4; ++m)
#pragma unroll
                    for (int n = 0; n < 2; ++n) acc[a][b][m][n] = (f32x4){0.f, 0.f, 0.f, 0.f};
        cur = nxt; cA = nA; cB = nB; ++ui;
        if (wr == 1) PG8_BAR;
    }
    PG8_WAIT_V(0);
    PG8_BAR;
#undef PG8_SA
#undef PG8_SB
#undef PG8_STAGE
#undef PG8_LDA
#undef PG8_LDB
#undef PG8_MMA
#undef PG8_WAIT_V
#undef PG8_WAIT_L
#undef PG8_BAR
#undef PG8_SCHED
}
}

template <int MODE>
__device__ __forceinline__ const float* conv_src(const float* src, const float* src2, int R) {
    if (MODE == 0) return src + R;
    if (MODE == 1) { const int pn = R >> 8, rho = R & 255; const int br = ((rho >> 7) << 1) | ((rho >> 4) & 1); const int c = pn * 64 + ((rho >> 5) & 3) * 16 + (rho & 15); return src + br * 2048 + c; }
    const int pn = R >> 8, rho = R & 255; return ((rho >> 7) ? src2 : src) + pn * 128 + (rho & 127);
}
template <int MODE>
__device__ __forceinline__ void conv_T(const float* src, const float* src2, int src_ld, bf16_t* dst, int K, int NR, LAS float* lds) {
    const int tid = otid();
    const int kt = K >> 7, ntiles = (NR >> 6) * kt;
    const int rr = tid & 63, kk0 = tid >> 6, kp = tid & 15, rr0 = tid >> 4;
    float v[16];
    int tl = obid();
    if (tl < ntiles) {
        const int R0 = (tl / kt) << 6, k0 = (tl % kt) << 7;
        const float* sp = conv_src<MODE>(src, src2, R0 + rr) + (size_t)(k0 + kk0) * src_ld;
#pragma unroll
        for (int i = 0; i < 16; ++i) v[i] = sp[(size_t)(8 * i) * src_ld];
    }
    for (int it = 0; tl < ntiles; tl += gridDim.x, ++it) {
        LAS float* tile = lds + (it & 1) * (128 * 65);
#pragma unroll
        for (int i = 0; i < 16; ++i) tile[(kk0 + 8 * i) * 65 + rr] = v[i];
        const int tn = tl + gridDim.x;
        if (tn < ntiles) {
            const int R0n = (tn / kt) << 6, k0n = (tn % kt) << 7;
            const float* sp = conv_src<MODE>(src, src2, R0n + rr) + (size_t)(k0n + kk0) * src_ld;
#pragma unroll
            for (int i = 0; i < 16; ++i) v[i] = sp[(size_t)(8 * i) * src_ld];
        }
        __syncthreads();
        const int R0 = (tl / kt) << 6, k0 = (tl % kt) << 7;
#pragma unroll
        for (int i = 0; i < 2; ++i) {
            const int r = rr0 + 32 * i;
            float f[8];
#pragma unroll
            for (int j = 0; j < 8; ++j) f[j] = tile[(8 * kp + j) * 65 + r];
            u32x4 o; o[0] = cvt_pk_bf16(f[0], f[1]); o[1] = cvt_pk_bf16(f[2], f[3]); o[2] = cvt_pk_bf16(f[4], f[5]); o[3] = cvt_pk_bf16(f[6], f[7]);
            *(u32x4*)(dst + (size_t)(R0 + r) * K + k0 + 8 * kp) = o;
        }
    }
    __syncthreads();
}

__device__ void convert_layer(const Params& p, int l, LAS float* tile) {
    unsigned char* ws = p.ws;
    conv_T<0>(p.in[I_WIN] + (size_t)l * D * INW, nullptr, INW, (bf16_t*)(ws + WS_WIN), D, INW, tile);
    conv_T<1>(p.in[I_WGATE] + (size_t)l * D * 8192, nullptr, 8192, (bf16_t*)(ws + WS_GATE), D, 8192, tile);
    for (int n = 0; n < 4; ++n)
        conv_T<0>(p.in[I_WBR] + ((size_t)l * 4 + n) * 512 * D, nullptr, D, (bf16_t*)(ws + WS_WB) + (size_t)n * 2048 * 512, 512, D, tile);
    conv_T<0>(p.in[I_WOUT] + (size_t)l * D * D, nullptr, D, (bf16_t*)(ws + WS_WO), D, D, tile);
    conv_T<2>(p.in[I_WFG] + (size_t)l * D * DFF, p.in[I_WFU] + (size_t)l * D * DFF, DFF, (bf16_t*)(ws + WS_GU), D, 2 * DFF, tile);
    conv_T<0>(p.in[I_WFD] + (size_t)l * DFF * D, nullptr, D, (bf16_t*)(ws + WS_WD), DFF, D, tile);
    bf16_t* sm = (bf16_t*)(ws + WS_SMALL) + (size_t)l * SMALL_L;
    for (int gI = 0; gI < 4; ++gI) conv_T<0>(p.in[I_WPOOL] + ((size_t)l * 4 + gI) * 16384, nullptr, 128, sm + (size_t)gI * 16384, 128, 128, tile);
    for (int gI = 0; gI < 8; ++gI) conv_T<0>(p.in[I_WRG] + ((size_t)l * 8 + gI) * 16384, nullptr, 128, sm + (size_t)(4 + gI) * 16384, 128, 128, tile);
    for (int gI = 0; gI < 8; ++gI) conv_T<0>(p.in[I_WIG] + ((size_t)l * 8 + gI) * 16384, nullptr, 128, sm + (size_t)(12 + gI) * 16384, 128, 128, tile);
    {
        const float* s = p.in[I_WSP] + (size_t)l * 65536; bf16_t* d = sm + (size_t)20 * 16384;
        for (int i = obid() * NTHR + otid(); i < 32768; i += gridDim.x * NTHR) *(unsigned*)(d + 2 * i) = cvt_pk_bf16(s[2 * i], s[2 * i + 1]);
    }
}

__device__ void phase_mod(const Params& p, LAS float* lds) {
    const int tid = otid();
    LAS float* cond = lds; LAS float* red = lds + 9 * 2048;
    for (int i = tid; i < 9 * 2048; i += NTHR) { const int r = i >> 11, k = i & 2047; const float v = r < 8 ? p.in[I_C][r * 2048 + k] : p.in[I_CCTX][k]; cond[i] = v * sigm(v); }
    __syncthreads();
    float* mod = (float*)(p.ws + WS_MOD);
    for (int chunk = obid(); chunk < 256; chunk += gridDim.x) {
        const int l = chunk >> 7, col0 = (chunk & 127) * 96;
        const float* W = p.in[I_WMOD] + (size_t)l * 2048 * 12288;
        if (tid < 384) {
            const int q = tid % 24, kg = tid / 24;
            float acc[9][4];
#pragma unroll
            for (int r = 0; r < 9; ++r)
#pragma unroll
                for (int j = 0; j < 4; ++j) acc[r][j] = 0.f;
            const float* wp = W + (size_t)(kg * 128) * 12288 + col0 + 4 * q;
#pragma unroll 8
            for (int kk = 0; kk < 128; ++kk) {
                const f32x4 w = *(const f32x4*)(wp + (size_t)kk * 12288);
#pragma unroll
                for (int r = 0; r < 9; ++r) { const float cv = cond[r * 2048 + kg * 128 + kk];
#pragma unroll
                    for (int j = 0; j < 4; ++j) acc[r][j] += cv * w[j]; }
            }
#pragma unroll
            for (int r = 0; r < 9; ++r)
#pragma unroll
                for (int j = 0; j < 4; ++j) red[kg * 864 + q * 36 + r * 4 + j] = acc[r][j];
        }
        __syncthreads();
        for (int o = tid; o < 864; o += NTHR) {
            const int r = o / 96, cc = o % 96, q = cc >> 2, j = cc & 3;
            float s = p.in[I_BMOD][l * 12288 + col0 + cc];
#pragma unroll
            for (int kg = 0; kg < 16; ++kg) s += red[kg * 864 + q * 36 + r * 4 + j];
            mod[((size_t)l * 9 + r) * 12288 + col0 + cc] = s;
        }
        __syncthreads();
    }
}

template <bool F32SRC>
__device__ void phase_norm(const float* xsrc, const float* csrc, const bf16_t* XRb, const float* gamma, const float* modl, int shi, int sci, bf16_t* H, int nrows) {
    const int tid_ = otid(); const int lane = tid_ & 63, gw = obid() * 8 + (tid_ >> 6), nw = gridDim.x * 8;
    for (int row = gw; row < nrows; row += nw) {
        const int brow = row < MX ? (row >> 11) : 8;
        float v[32]; float ss = 0.f;
        if (F32SRC) {
            const float* src = row < MX ? xsrc + (size_t)row * D : csrc + (size_t)(row - MX) * D;
#pragma unroll
            for (int i = 0; i < 4; ++i) { const f32x4 a = *(const f32x4*)(src + 8 * (lane + 64 * i)), b = *(const f32x4*)(src + 8 * (lane + 64 * i) + 4);
#pragma unroll
                for (int j = 0; j < 4; ++j) { v[8 * i + j] = a[j]; v[8 * i + 4 + j] = b[j]; } }
        } else {
#pragma unroll
            for (int i = 0; i < 4; ++i) { const u32x4 a = *(const u32x4*)(XRb + (size_t)row * D + 8 * (lane + 64 * i));
#pragma unroll
                for (int j = 0; j < 4; ++j) { v[8 * i + 2 * j] = bflo(a[j]); v[8 * i + 2 * j + 1] = bfhi(a[j]); } }
        }
#pragma unroll
        for (int i = 0; i < 32; ++i) ss += v[i] * v[i];
        ss = wave_sum(ss);
        const float rstd = rsqrtf(ss * (1.f / D) + 1e-6f);
        const float* shp = modl + (size_t)brow * 12288 + shi * 2048; const float* scp = modl + (size_t)brow * 12288 + sci * 2048;
#pragma unroll
        for (int i = 0; i < 4; ++i) {
            const int col = 8 * (lane + 64 * i);
            float y[8];
#pragma unroll
            for (int hh = 0; hh < 2; ++hh) { const f32x4 g = *(const f32x4*)(gamma + col + 4 * hh), sc = *(const f32x4*)(scp + col + 4 * hh), sh = *(const f32x4*)(shp + col + 4 * hh);
#pragma unroll
                for (int j = 0; j < 4; ++j) y[4 * hh + j] = v[8 * i + 4 * hh + j] * rstd * g[j] * (1.f + sc[j]) + sh[j]; }
            u32x4 o; o[0] = cvt_pk_bf16(y[0], y[1]); o[1] = cvt_pk_bf16(y[2], y[3]); o[2] = cvt_pk_bf16(y[4], y[5]); o[3] = cvt_pk_bf16(y[6], y[7]);
            *(u32x4*)(H + (size_t)row * D + col) = o;
        }
    }
}
__device__ void phase_final(const bf16_t* XRb, const float* gamma, float* out) {
    const int tid_ = otid(); const int lane = tid_ & 63, gw = obid() * 8 + (tid_ >> 6), nw = gridDim.x * 8;
    for (int row = gw; row < MX; row += nw) {
        float v[32]; float ss = 0.f;
#pragma unroll
        for (int i = 0; i < 4; ++i) { const u32x4 a = *(const u32x4*)(XRb + (size_t)row * D + 8 * (lane + 64 * i));
#pragma unroll
            for (int j = 0; j < 4; ++j) { v[8 * i + 2 * j] = bflo(a[j]); v[8 * i + 2 * j + 1] = bfhi(a[j]); } }
#pragma unroll
        for (int i = 0; i < 32; ++i) ss += v[i] * v[i];
        ss = wave_sum(ss);
        const float rstd = rsqrtf(ss * (1.f / D) + 1e-6f);
#pragma unroll
        for (int i = 0; i < 4; ++i) { const int col = 8 * (lane + 64 * i);
#pragma unroll
            for (int hh = 0; hh < 2; ++hh) { const f32x4 g = *(const f32x4*)(gamma + col + 4 * hh); f32x4 y;
#pragma unroll
                for (int j = 0; j < 4; ++j) y[j] = v[8 * i + 4 * hh + j] * rstd * g[j];
                *(f32x4*)(out + (size_t)row * D + col + 4 * hh) = y; } }
    }
}

constexpr int LDT = 136;
constexpr int L_X = 0, L_Y1 = 34816, L_Y2 = 69632, L_MISC = 110592;

__device__ __forceinline__ void mm128(const LAS bf16_t* X, const LAS bf16_t* Y, int w, int lr, int quad, f32x4 (&acc)[8]) {
#pragma unroll
    for (int kk = 0; kk < 4; ++kk) {
        const bf16x8 a = *(const LAS bf16x8*)(X + (16 * w + lr) * LDT + kk * 32 + quad * 8);
#pragma unroll
        for (int jt = 0; jt < 8; ++jt) {
            const bf16x8 b = *(const LAS bf16x8*)(Y + (16 * jt + lr) * LDT + kk * 32 + quad * 8);
            acc[jt] = __builtin_amdgcn_mfma_f32_16x16x32_bf16(a, b, acc[jt], 0, 0, 0);
        }
    }
}
__device__ __forceinline__ void mm128T(const LAS bf16_t* X, const LAS bf16_t* Y, int w, int lr, int quad, f32x4 (&acc)[8]) {
#pragma unroll
    for (int kk = 0; kk < 4; ++kk) {
        const bf16x8 a = *(const LAS bf16x8*)(X + (16 * w + lr) * LDT + kk * 32 + quad * 8);
#pragma unroll
        for (int jt = 0; jt < 8; ++jt) {
            const bf16x8 b = *(const LAS bf16x8*)(Y + (16 * jt + lr) * LDT + kk * 32 + quad * 8);
            acc[jt] = __builtin_amdgcn_mfma_f32_16x16x32_bf16(b, a, acc[jt], 0, 0, 0);
        }
    }
}
__device__ __forceinline__ void load_w128(const bf16_t* src, LAS bf16_t* dst) {
    const int tid0 = otid();
#pragma unroll
    for (int i = 0; i < 4; ++i) { const int idx = tid0 + NTHR * i; const int row = idx >> 4, c8 = (idx & 15) * 8;
        *(LAS u32x4*)(dst + row * LDT + c8) = *(const u32x4*)(src + row * 128 + c8); }
}
__device__ __forceinline__ void tile_seq(int slot, int b, int& seqrow0, int& L, int& t0) {
    if (slot < 2) { seqrow0 = MX + b * CTXL; L = CTXL; t0 = slot * 128; } else { seqrow0 = b * SEQ; L = SEQ; t0 = (slot - 2) * 128; }
}

__device__ void lru_tiles(const Params& p, int l, bool final_mode, bool skip_ctx, LAS unsigned char* lds) {
    const int rot = final_mode ? 0 : 24;
    const int tid = otid(), w = tid >> 6, lane = tid & 63, lr = lane & 15, quad = lane >> 4;
    const bf16_t* XIN = (const bf16_t*)(p.ws + WS_Q); bf16_t* YS = (bf16_t*)(p.ws + WS_YS);
    float* AGG = (float*)(p.ws + WS_AGG); unsigned* AB = (unsigned*)(p.ws + WS_AB);
    const bf16_t* sm = (const bf16_t*)(p.ws + WS_SMALL) + (size_t)l * SMALL_L;
    LAS bf16_t* X = (LAS bf16_t*)(lds + L_X);
    LAS float* hst = (LAS float*)(lds + L_MISC);
    const float* convw = p.in[I_CONVW] + (size_t)l * 4 * 512; const float* convb = p.in[I_CONVB] + (size_t)l * 512;
    const int chl = 16 * w + lr;
    const int xb = obid() & 7, xs = obid() >> 3, xn = max((int)gridDim.x >> 3, 1);
    for (int lt = (xs + rot) % xn; lt < 72; lt += xn) {
        const int tile = xb * 72 + lt;
        const int g = tile & 3, slot = (tile >> 2) % 18, b = tile / 72;
        if (skip_ctx && slot < 2) continue;
        int seqrow0, L, t0; tile_seq(slot, b, seqrow0, L, t0);
        const int ch = g * 128 + chl;
        if (!final_mode) {
            const int t = tid >> 2, part = tid & 3;
#pragma unroll
            for (int c8i = 0; c8i < 4; ++c8i) {
                const int c = part * 32 + c8i * 8, chc = g * 128 + c;
                float o[8];
                { const f32x4 b0 = *(const f32x4*)(convb + chc), b1 = *(const f32x4*)(convb + chc + 4);
#pragma unroll
                  for (int j = 0; j < 4; ++j) { o[j] = b0[j]; o[4 + j] = b1[j]; } }
#pragma unroll
                for (int k = 0; k < 4; ++k) {
                    const int tt = t0 + t + k - 2;
                    const bool okk = tt >= 0 && tt < L;
                    const int ttc = okk ? tt : t0 + t;
                    u32x4 zv = *(const u32x4*)(XIN + (size_t)(seqrow0 + ttc) * INW + 1536 + chc);
                    if (!okk) zv = (u32x4){0u, 0u, 0u, 0u};
                    const f32x4 w0 = *(const f32x4*)(convw + k * 512 + chc), w1 = *(const f32x4*)(convw + k * 512 + chc + 4);
                    o[0] += w0[0] * bflo(zv[0]); o[1] += w0[1] * bfhi(zv[0]); o[2] += w0[2] * bflo(zv[1]); o[3] += w0[3] * bfhi(zv[1]);
                    o[4] += w1[0] * bflo(zv[2]); o[5] += w1[1] * bfhi(zv[2]); o[6] += w1[2] * bflo(zv[3]); o[7] += w1[3] * bfhi(zv[3]);
                }
                u32x4 ov; ov[0] = cvt_pk_bf16(o[0], o[1]); ov[1] = cvt_pk_bf16(o[2], o[3]); ov[2] = cvt_pk_bf16(o[4], o[5]); ov[3] = cvt_pk_bf16(o[6], o[7]);
                *(LAS u32x4*)(X + t * LDT + c) = ov;
            }
        }
        if (final_mode && tid < 256) {
            const int dir = tid >> 7, chq = tid & 127;
            const float* ag = AGG + (((size_t)dir * 8 + b) * 18) * 1024 + (g * 128 + chq) * 2;
            float Ag[18], Bg[18];
#pragma unroll
            for (int s2 = 0; s2 < 18; ++s2) { Ag[s2] = ag[s2 * 1024]; Bg[s2] = ag[s2 * 1024 + 1]; }
            float h = 0.f;
            if (dir == 0) {
#pragma unroll
                for (int s2 = 0; s2 < 18; ++s2) if (s2 < slot) h = h * Ag[s2] + Bg[s2];
            } else {
                const int pos = slot == 1 ? 0 : (slot == 0 ? 1 : 19 - slot);
#pragma unroll
                for (int i = 0; i < 18; ++i) { const int s2 = i == 0 ? 1 : (i == 1 ? 0 : 19 - i); if (i < pos) h = h * Ag[s2] + Bg[s2]; }
            }
            hst[dir * 128 + chq] = h;
        }
        __syncthreads();
        f32x4 hsum[8];
#pragma unroll
        for (int rt = 0; rt < 8; ++rt) hsum[rt] = (f32x4){0.f, 0.f, 0.f, 0.f};
        const size_t abrow = (size_t)((seqrow0 + t0 + 4 * quad) >> 2);
        if (!final_mode) {
            bf16x8 bw[4][4];
#pragma unroll
            for (int mt = 0; mt < 4; ++mt) {
                const bf16_t* wp_ = sm + (size_t)(((mt & 1) ? 12 : 4) + (mt >> 1) * 4 + g) * 16384 + chl * 128 + 8 * quad;
#pragma unroll
                for (int kk = 0; kk < 4; ++kk) bw[mt][kk] = *(const bf16x8*)(wp_ + 32 * kk);
            }
            float brg[2], big[2], sp[2];
#pragma unroll
            for (int dir = 0; dir < 2; ++dir) {
                brg[dir] = p.in[I_BRG][(l * 2 + dir) * 512 + ch]; big[dir] = p.in[I_BIG][(l * 2 + dir) * 512 + ch];
                const float lam = p.in[I_LAM][(l * 2 + dir) * 512 + ch];
                sp[dir] = (lam < -15.f) ? -lam : __logf(1.f + __expf(-lam));
            }
            float fA[2][8], fB[2][8];
#pragma unroll
            for (int rt = 0; rt < 8; ++rt) {
                f32x4 acc4[4];
#pragma unroll
                for (int mt = 0; mt < 4; ++mt) acc4[mt] = (f32x4){0.f, 0.f, 0.f, 0.f};
#pragma unroll
                for (int kk = 0; kk < 4; ++kk) {
                    const bf16x8 xa = *(const LAS bf16x8*)(X + (16 * rt + lr) * LDT + kk * 32 + quad * 8);
#pragma unroll
                    for (int mt = 0; mt < 4; ++mt) acc4[mt] = __builtin_amdgcn_mfma_f32_16x16x32_bf16(xa, bw[mt][kk], acc4[mt], 0, 0, 0);
                }
                float z[4];
#pragma unroll
                for (int jj = 0; jj < 4; ++jj) z[jj] = bf2f(X[(16 * rt + 4 * quad + jj) * LDT + chl]);
#pragma unroll
                for (int dir = 0; dir < 2; ++dir) {
                    float ea[4], bv[4]; u32x4 wv;
#pragma unroll
                    for (int jj = 0; jj < 4; ++jj) {
                        const float rr = sigm(acc4[2 * dir][jj] + brg[dir]), ii = sigm(acc4[2 * dir + 1][jj] + big[dir]);
                        const unsigned lab = cvt_pk_bf16(-8.f * rr * sp[dir], 0.f) & 0xffffu;
                        const float la = bflo(lab);
                        const float x2 = 2.f * la, e_ = fexp(la);
                        const float omp = -x2 * (1.f + x2 * (0.5f + x2 * (0.16666667f + x2 * 0.041666668f))), oma = 1.f - e_ * e_;
                        const float om = oma + (omp - oma) * ((x2 > -0.125f) ? 1.f : 0.f);
                        const unsigned pw = cvt_pk_bf16(la, __builtin_amdgcn_sqrtf(om) * (ii * z[jj]));
                        ea[jj] = e_; bv[jj] = bfhi(pw); wv[jj] = pw;
                    }
                    *(u32x4*)(AB + (((size_t)dir * (MT / 4) + abrow + 4 * rt) * 512 + ch) * 4) = wv;
                    float A, Bv;
                    if (dir == 0) { A = ea[0]; Bv = bv[0];
#pragma unroll
                        for (int jj = 1; jj < 4; ++jj) { Bv = Bv * ea[jj] + bv[jj]; A *= ea[jj]; } }
                    else { A = ea[3]; Bv = bv[3];
#pragma unroll
                        for (int jj = 2; jj >= 0; --jj) { Bv = Bv * ea[jj] + bv[jj]; A *= ea[jj]; } }
                    fA[dir][rt] = A; fB[dir][rt] = Bv;
                }
            }
#pragma unroll
            for (int dir = 0; dir < 2; ++dir) {
                float Arun = 1.f, Brun = 0.f;
#pragma unroll
                for (int s1 = 0; s1 < 8; ++s1) {
                    const int rt = dir ? 7 - s1 : s1;
                    float At = 1.f, Bt = 0.f;
#pragma unroll
                    for (int s2 = 0; s2 < 4; ++s2) {
                        const int qq = dir ? 3 - s2 : s2;
                        const float Ao = __shfl(fA[dir][rt], lr + 16 * qq), Bo = __shfl(fB[dir][rt], lr + 16 * qq);
                        Bt = Bt * Ao + Bo; At *= Ao;
                    }
                    Brun = Brun * At + Bt; Arun *= At;
                }
                if (quad == 0) { float* ag = AGG + ((((size_t)dir * 8 + b) * 18 + slot) * 512 + ch) * 2; ag[0] = Arun; ag[1] = Brun; }
            }
        } else {
#pragma unroll 1
        for (int dir = 0; dir < 2; ++dir) {
            const bool rev = dir == 1;
            f32x4 a[8], bb[8];
            {
                u32x4 raw[8];
#pragma unroll
                for (int rt = 0; rt < 8; ++rt) raw[rt] = *(const u32x4*)(AB + (((size_t)dir * (MT / 4) + abrow + 4 * rt) * 512 + ch) * 4);
#pragma unroll
                for (int rt = 0; rt < 8; ++rt)
#pragma unroll
                    for (int jj = 0; jj < 4; ++jj) { a[rt][jj] = fexp(bflo(raw[rt][jj])); bb[rt][jj] = bfhi(raw[rt][jj]); }
            }
            float h = hst[dir * 128 + chl];
#pragma unroll
            for (int s1 = 0; s1 < 8; ++s1) {
                const int rt = rev ? 7 - s1 : s1;
                float A, Bv;
                if (!rev) { A = a[rt][0]; Bv = bb[rt][0];
#pragma unroll
                    for (int jj = 1; jj < 4; ++jj) { Bv = Bv * a[rt][jj] + bb[rt][jj]; A *= a[rt][jj]; } }
                else { A = a[rt][3]; Bv = bb[rt][3];
#pragma unroll
                    for (int jj = 2; jj >= 0; --jj) { Bv = Bv * a[rt][jj] + bb[rt][jj]; A *= a[rt][jj]; } }
                float Ap = 1.f, Bp = 0.f, At = 1.f, Bt = 0.f;
#pragma unroll
                for (int s2 = 0; s2 < 4; ++s2) {
                    const int qq = rev ? 3 - s2 : s2;
                    const float Ao = __shfl(A, lr + 16 * qq), Bo = __shfl(Bv, lr + 16 * qq);
                    const bool before = rev ? (qq > quad) : (qq < quad);
                    if (before) { Bp = Bp * Ao + Bo; Ap *= Ao; }
                    Bt = Bt * Ao + Bo; At *= Ao;
                }
                float hh = h * Ap + Bp;
                if (!rev) {
#pragma unroll
                    for (int jj = 0; jj < 4; ++jj) { hh = a[rt][jj] * hh + bb[rt][jj]; hsum[rt][jj] += hh; } }
                else {
#pragma unroll
                    for (int jj = 3; jj >= 0; --jj) { hh = a[rt][jj] * hh + bb[rt][jj]; hsum[rt][jj] += hh; } }
                h = h * At + Bt;
            }
        }
        }
        if (final_mode) {
#pragma unroll
            for (int rt = 0; rt < 8; ++rt)
#pragma unroll
                for (int jj = 0; jj < 4; ++jj) {
                    const size_t row = (size_t)seqrow0 + t0 + 16 * rt + 4 * quad + jj;
                    const float lg = bf2f(XIN[row * INW + 2048 + ch]);
                    YS[row * D + 1024 + ch] = f2bf(hsum[rt][jj] * gelu_tanh(lg));
                }
        }
        __syncthreads();
    }
}

__device__ void pool_tiles(const Params& p, int l, bool skip_ctx, LAS unsigned char* lds) {
    const int tid = otid(), w = tid >> 6, lane = tid & 63, lr = lane & 15, quad = lane >> 4;
    const bf16_t* XIN = (const bf16_t*)(p.ws + WS_Q); bf16_t* YS = (bf16_t*)(p.ws + WS_YS);
    const bf16_t* sm = (const bf16_t*)(p.ws + WS_SMALL) + (size_t)l * SMALL_L;
    LAS bf16_t* X = (LAS bf16_t*)(lds + L_X); LAS bf16_t* Y1 = (LAS bf16_t*)(lds + L_Y1); LAS bf16_t* ZS = (LAS bf16_t*)(lds + L_Y2);
    const int xb = obid() & 7, xs = obid() >> 3, xn = max((int)gridDim.x >> 3, 1);
    for (int lt = (xs + 24) % xn; lt < 72; lt += xn) {
        const int tile = xb * 72 + lt;
        const int g = tile & 3, slot = (tile >> 2) % 18, b = tile / 72;
        if (skip_ctx && slot < 2) continue;
        int seqrow0, L, t0; tile_seq(slot, b, seqrow0, L, t0);
        const int half = 1 << g;
        load_w128(sm + (size_t)g * 16384, Y1);
        for (int idx = tid; idx < 144 * 16; idx += NTHR) {
            const int rrow = idx >> 4, c8 = (idx & 15) * 8, tt = t0 - 8 + rrow;
            u32x4 v = (u32x4){0u, 0u, 0u, 0u};
            if (tt >= 0 && tt < L) v = *(const u32x4*)(XIN + (size_t)(seqrow0 + tt) * INW + g * 128 + c8);
            *(LAS u32x4*)(ZS + rrow * LDT + c8) = v;
        }
        __syncthreads();
        {
            const int t = tid >> 2, part = tid & 3, tt = t0 + t;
            const int lo = max(tt - half, 0), hi = min(tt + half, L);
            const float inv = 1.f / (float)(hi - lo);
#pragma unroll
            for (int c8i = 0; c8i < 4; ++c8i) {
                const int c = part * 32 + c8i * 8;
                float s[8];
#pragma unroll
                for (int j = 0; j < 8; ++j) s[j] = 0.f;
                for (int q = lo; q < hi; ++q) {
                    const u32x4 v = *(const LAS u32x4*)(ZS + (q - t0 + 8) * LDT + c);
#pragma unroll
                    for (int j = 0; j < 4; ++j) { s[2 * j] += bflo(v[j]); s[2 * j + 1] += bfhi(v[j]); }
                }
                const u32x4 zc = *(const LAS u32x4*)(ZS + (t + 8) * LDT + c);
#pragma unroll
                for (int j = 0; j < 4; ++j) { s[2 * j] = s[2 * j] * inv - bflo(zc[j]); s[2 * j + 1] = s[2 * j + 1] * inv - bfhi(zc[j]); }
                u32x4 ov; ov[0] = cvt_pk_bf16(s[0], s[1]); ov[1] = cvt_pk_bf16(s[2], s[3]); ov[2] = cvt_pk_bf16(s[4], s[5]); ov[3] = cvt_pk_bf16(s[6], s[7]);
                *(LAS u32x4*)(X + t * LDT + c) = ov;
            }
        }
        __syncthreads();
        f32x4 acc[8];
#pragma unroll
        for (int jt = 0; jt < 8; ++jt) acc[jt] = (f32x4){0.f, 0.f, 0.f, 0.f};
        mm128T(X, Y1, w, lr, quad, acc);
        {
            const size_t row = (size_t)seqrow0 + t0 + 16 * w + lr;
#pragma unroll
            for (int jt = 0; jt < 8; ++jt) {
                const int ch = g * 128 + 16 * jt + 4 * quad; const f32x4 ps = *(const f32x4*)(p.in[I_PSCALE] + l * 512 + ch);
                u32x2 o; o[0] = cvt_pk_bf16(acc[jt][0] * ps[0], acc[jt][1] * ps[1]); o[1] = cvt_pk_bf16(acc[jt][2] * ps[2], acc[jt][3] * ps[3]);
                *(u32x2*)(YS + row * D + ch) = o;
            }
        }
        __syncthreads();
    }
}

__device__ void sgu_tiles(const Params& p, int l, bool skip_ctx, LAS unsigned char* lds) {
    const int tid = otid(), w = tid >> 6, lane = tid & 63, lr = lane & 15, quad = lane >> 4;
    const bf16_t* XIN = (const bf16_t*)(p.ws + WS_Q); bf16_t* YS = (bf16_t*)(p.ws + WS_YS);
    const bf16_t* sm = (const bf16_t*)(p.ws + WS_SMALL) + (size_t)l * SMALL_L;
    LAS bf16_t* X = (LAS bf16_t*)(lds + L_X); LAS bf16_t* Y1 = (LAS bf16_t*)(lds + L_Y1);
    const int xb = obid() & 7, xs = obid() >> 3, xn = max((int)gridDim.x >> 3, 1);
    for (int lt = (xs + 16) % xn; lt < 72; lt += xn) {
        const int tile = xb * 72 + lt;
        const int g = tile & 3, slot = (tile >> 2) % 18, b = tile / 72;
        if (skip_ctx && slot < 2) continue;
        int seqrow0, L, t0; tile_seq(slot, b, seqrow0, L, t0);
        load_w128(sm + (size_t)(20 + g) * 16384, X);
        {
            const int t = tid >> 2, part = tid & 3;
            const bf16_t* vrow = XIN + (size_t)(seqrow0 + t0 + t) * INW + 1024;
            float s1 = 0.f, s2 = 0.f;
#pragma unroll
            for (int i = 0; i < 16; ++i) { const u32x4 v = *(const u32x4*)(vrow + part * 128 + i * 8);
#pragma unroll
                for (int j = 0; j < 4; ++j) { const float x0 = bflo(v[j]), x1 = bfhi(v[j]); s1 += x0 + x1; s2 += x0 * x0 + x1 * x1; } }
            s1 += __shfl_xor(s1, 1); s2 += __shfl_xor(s2, 1); s1 += __shfl_xor(s1, 2); s2 += __shfl_xor(s2, 2);
            const float mean = s1 * (1.f / 512.f); const float var = fmaxf(s2 * (1.f / 512.f) - mean * mean, 0.f);
            const float rstd = rsqrtf(var + 1e-6f);
#pragma unroll
            for (int i = 0; i < 4; ++i) {
                const int c = part * 32 + i * 8;
                const u32x4 v = *(const u32x4*)(vrow + g * 128 + c);
                const float* lg = p.in[I_LNG] + l * 512 + g * 128 + c;
#pragma unroll
                for (int j = 0; j < 4; ++j) {
                    Y1[(c + 2 * j) * LDT + t] = f2bf((bflo(v[j]) - mean) * rstd * lg[2 * j]);
                    Y1[(c + 2 * j + 1) * LDT + t] = f2bf((bfhi(v[j]) - mean) * rstd * lg[2 * j + 1]);
                }
            }
        }
        __syncthreads();
        f32x4 acc[8];
#pragma unroll
        for (int jt = 0; jt < 8; ++jt) acc[jt] = (f32x4){0.f, 0.f, 0.f, 0.f};
        mm128T(X, Y1, w, lr, quad, acc);
        {
            const int pp = 16 * w + lr; const float bs = p.in[I_BSP][(l * 4 + g) * 128 + pp];
            const size_t row = (size_t)seqrow0 + t0 + pp;
#pragma unroll
            for (int jt = 0; jt < 8; ++jt) {
                const int ch = g * 128 + 16 * jt + 4 * quad;
                const u32x2 uv = *(const u32x2*)(XIN + row * INW + 512 + ch);
                u32x2 o; o[0] = cvt_pk_bf16(bflo(uv[0]) * (acc[jt][0] + bs), bfhi(uv[0]) * (acc[jt][1] + bs)); o[1] = cvt_pk_bf16(bflo(uv[1]) * (acc[jt][2] + bs), bfhi(uv[1]) * (acc[jt][3] + bs));
                *(u32x2*)(YS + row * D + 512 + ch) = o;
            }
        }
        __syncthreads();
    }
}

constexpr int AK_LD = 136, AV_LD = 72, A_SLOT = 64 * AK_LD * 2 + 128 * AV_LD * 2;
__device__ void attn_tasks(const Params& p, int l, bool with_ctx, LAS unsigned char* lds) {
    const int tid = otid(), w = tid >> 6, lane = tid & 63, lr = lane & 15, quad = lane >> 4;
    const bf16_t* XIN = (const bf16_t*)(p.ws + WS_Q); bf16_t* YS = (bf16_t*)(p.ws + WS_YS);
    const bf16_t* VT = (const bf16_t*)(p.ws + WS_VT); const bf16_t* VTC = (const bf16_t*)(p.ws + WS_VTC);
    const float scale = 0.08838834764831845f;
    const int ntask = 512 + (with_ctx ? 64 : 0);
    LAS float* rpbs = (LAS float*)(lds + L_MISC + 12288);
    for (int i = tid; i < 4 * 465; i += NTHR) rpbs[i] = p.in[I_RPB][(size_t)l * 4 * 465 + i];
    __syncthreads();
    const int krow_t = tid >> 3, kcol_t = (tid & 7) * 16, vrow_t = tid >> 2, vcol_t = (tid & 3) * 16;
    const int xb = obid() & 7, xs = obid() >> 3, xn = max((int)gridDim.x >> 3, 1);
    for (int lt = xs; lt < 64 + (with_ctx ? 8 : 0); lt += xn) {
        const int task = lt < 64 ? xb * 64 + lt : 512 + xb * 8 + (lt - 64);
        const bool isx = task < 512;
        int b, h, r0 = 0, nloc = 0, krow0 = 0, half = 0;
        if (isx) { b = task >> 6; h = (task >> 4) & 3; r0 = (task & 15) * 2; const int rsa = min(max(r0 - 4, 0), 24), rsb = min(max(r0 - 3, 0), 24); krow0 = rsa; nloc = rsb + 8 - rsa; }
        else { const int tc = task - 512; b = tc >> 3; h = (tc >> 1) & 3; half = tc & 1; }
        const int T = nloc + 4;
        const int rq = r0 + (w >> 2), j = w & 3;
        const int qrow0 = isx ? (b * SEQ + rq * 64 + 16 * j) : (MX + b * CTXL + half * 128 + 16 * w);
        const int rs = min(max(rq - 4, 0), 24);
        const int wsc = j == 0 ? 0 : (j == 1 ? 8 : (j == 2 ? 24 : 32));
        const int cq = 16 * j + lr, cs = min(max(cq - 8, 0), 48);
        const LAS float* rpb = rpbs + h * 465;
        bf16x8 qf[4];
#pragma unroll
        for (int kk = 0; kk < 4; ++kk) qf[kk] = *(const bf16x8*)(XIN + (size_t)(qrow0 + lr) * INW + 2560 + h * 128 + 32 * kk + 8 * quad);
        float mx = -3.0e38f, lsum = 0.f;
        f32x4 O[8];
#pragma unroll
        for (int dt = 0; dt < 8; ++dt) O[dt] = (f32x4){0.f, 0.f, 0.f, 0.f};
        u32x4 kr0, kr1, vr0, vr1;
#define ATT_GLOAD(t) do { const bool lt_ = (t) < nloc; \
            const bf16_t* kp_ = XIN + (size_t)(lt_ ? (b * SEQ + (krow0 + (t)) * 64) : (MX + b * CTXL + ((t) - nloc) * 64)) * INW + 3072 + h * 128 + (size_t)krow_t * INW + kcol_t; \
            kr0 = *(const u32x4*)kp_; kr1 = *(const u32x4*)(kp_ + 8); \
            const bf16_t* vp_ = lt_ ? (VT + ((size_t)(b * 4 + h) * 128 + vrow_t) * SEQ + (krow0 + (t)) * 64 + vcol_t) : (VTC + ((size_t)(b * 4 + h) * 128 + vrow_t) * CTXL + ((t) - nloc) * 64 + vcol_t); \
            vr0 = *(const u32x4*)vp_; vr1 = *(const u32x4*)(vp_ + 8); } while (0)
#define ATT_LWRITE(slot) do { LAS bf16_t* Ks_ = (LAS bf16_t*)(lds + (slot) * A_SLOT); LAS bf16_t* Vs_ = Ks_ + 64 * AK_LD; \
            *(LAS u32x4*)(Ks_ + krow_t * AK_LD + kcol_t) = kr0; *(LAS u32x4*)(Ks_ + krow_t * AK_LD + kcol_t + 8) = kr1; \
            *(LAS u32x4*)(Vs_ + vrow_t * AV_LD + vcol_t) = vr0; *(LAS u32x4*)(Vs_ + vrow_t * AV_LD + vcol_t + 8) = vr1; } while (0)
#define ATT_STEP(sv, Vs_, kb) do { float tm_ = sv[0]; _Pragma("unroll") for (int e_ = 1; e_ < 8; ++e_) tm_ = fmaxf(tm_, sv[e_]); \
            tm_ = fmaxf(tm_, __shfl_xor(tm_, 16)); tm_ = fmaxf(tm_, __shfl_xor(tm_, 32)); \
            const float mn_ = fmaxf(mx, tm_); const float al_ = fexp(mx - mn_); mx = mn_; \
            float ps_ = 0.f; _Pragma("unroll") for (int e_ = 0; e_ < 8; ++e_) { sv[e_] = fexp(sv[e_] - mn_); ps_ += sv[e_]; } \
            lsum = lsum * al_ + ps_; \
            if (__builtin_amdgcn_ballot_w64(al_ != 1.f) != 0ull) { _Pragma("unroll") for (int dt_ = 0; dt_ < 8; ++dt_) O[dt_] *= al_; } \
            u32x4 pa_; pa_[0] = cvt_pk_bf16(sv[0], sv[1]); pa_[1] = cvt_pk_bf16(sv[2], sv[3]); pa_[2] = cvt_pk_bf16(sv[4], sv[5]); pa_[3] = cvt_pk_bf16(sv[6], sv[7]); \
            const bf16x8 paf_ = __builtin_bit_cast(bf16x8, pa_); \
            _Pragma("unroll") for (int dt_ = 0; dt_ < 8; ++dt_) { const bf16x8 vv_ = *(const LAS bf16x8*)((Vs_) + (16 * dt_ + lr) * AV_LD + (kb) + 8 * quad); \
                O[dt_] = __builtin_amdgcn_mfma_f32_16x16x32_bf16(vv_, paf_, O[dt_], 0, 0, 0); } } while (0)
        ATT_GLOAD(0); ATT_LWRITE(0);
        ATT_GLOAD(1);
        __syncthreads();
        for (int t = 0; t < T; ++t) {
            const LAS bf16_t* Ks = (const LAS bf16_t*)(lds + (t & 1) * A_SLOT); const LAS bf16_t* Vs = Ks + 64 * AK_LD;
            if (t < nloc) {
                const int kabs = krow0 + t;
                if (kabs >= rs && kabs < rs + 8) {
                    const int drow = kabs - rq + 7;
                    float sv[8];
#pragma unroll
                    for (int hf = 0; hf < 2; ++hf) {
                        const LAS bf16_t* kp = Ks + (wsc + 8 * (lr >> 2) + 4 * hf + (lr & 3)) * AK_LD + 8 * quad;
                        f32x4 a = (f32x4){0.f, 0.f, 0.f, 0.f};
#pragma unroll
                        for (int kk = 0; kk < 4; ++kk) a = __builtin_amdgcn_mfma_f32_16x16x32_bf16(*(const LAS bf16x8*)(kp + 32 * kk), qf[kk], a, 0, 0, 0);
#pragma unroll
                        for (int jj = 0; jj < 4; ++jj) {
                            const int kc = wsc + 8 * quad + 4 * hf + jj;
                            const int dcol = min(max(kc - cq + 15, 0), 30);
                            const bool ok = (kc >= cs) && (kc < cs + 16);
                            const float bv = rpb[drow * 31 + dcol];
                            sv[hf * 4 + jj] = ok ? a[jj] * scale + bv : -1e30f;
                        }
                    }
                    ATT_STEP(sv, Vs, wsc);
                }
            } else {
#pragma unroll
                for (int ks = 0; ks < 2; ++ks) {
                    float sv[8];
#pragma unroll
                    for (int hf = 0; hf < 2; ++hf) {
                        const LAS bf16_t* kp = Ks + (32 * ks + 8 * (lr >> 2) + 4 * hf + (lr & 3)) * AK_LD + 8 * quad;
                        f32x4 a = (f32x4){0.f, 0.f, 0.f, 0.f};
#pragma unroll
                        for (int kk = 0; kk < 4; ++kk) a = __builtin_amdgcn_mfma_f32_16x16x32_bf16(*(const LAS bf16x8*)(kp + 32 * kk), qf[kk], a, 0, 0, 0);
#pragma unroll
                        for (int jj = 0; jj < 4; ++jj) sv[hf * 4 + jj] = a[jj] * scale;
                    }
                    ATT_STEP(sv, Vs, 32 * ks);
                }
            }
            if (t + 1 < T) { ATT_LWRITE((t + 1) & 1); if (t + 2 < T) ATT_GLOAD(t + 2); }
            __syncthreads();
        }
#undef ATT_GLOAD
#undef ATT_LWRITE
#undef ATT_STEP
        lsum += __shfl_xor(lsum, 16); lsum += __shfl_xor(lsum, 32);
        const float linv = 1.f / lsum;
        {
            bf16_t* op = YS + (size_t)(qrow0 + lr) * D + 1536 + h * 128 + 4 * quad;
#pragma unroll
            for (int dt = 0; dt < 8; ++dt) { u32x2 o; o[0] = cvt_pk_bf16(O[dt][0] * linv, O[dt][1] * linv); o[1] = cvt_pk_bf16(O[dt][2] * linv, O[dt][3] * linv); *(u32x2*)(op + 16 * dt) = o; }
        }
    }
}

#define XB_TMO      128
#define XB_XCNT(j)  (256  + 64 * (j))
#define XB_XSUB(j)  (1280 + 64 * (j))
#define XB_XGEN(j)  (2304 + 64 * (j))
#define XB_TOP      3328
#define XB_TOPGEN   3392
#define XCD_BAR_WORDS 3456
#define XB_SPIN_CAP (1u << 18)

__device__ __forceinline__ unsigned xb_ld(unsigned* p)              { return __hip_atomic_load(p, __ATOMIC_RELAXED, __HIP_MEMORY_SCOPE_AGENT); }
__device__ __forceinline__ unsigned xb_add(unsigned* p, unsigned v) { return __hip_atomic_fetch_add(p, v, __ATOMIC_RELAXED, __HIP_MEMORY_SCOPE_AGENT); }
__device__ __forceinline__ unsigned xb_xcc_id() { return (unsigned)__builtin_amdgcn_s_getreg((3 << 11) | 20) & 0xFu; }
#define XB_SPIN(cond, bar) do { unsigned _sp = 0; while (cond) { __builtin_amdgcn_s_sleep(1); \
    if ((++_sp & 255u) == 0u) { if (xb_ld(&(bar)[XB_TMO])) break; if (_sp > XB_SPIN_CAP) { atomicAdd(&(bar)[XB_TMO], 1u); break; } } } } while (0)

struct XcdBarrier {
    unsigned* bar; unsigned x;
    volatile LAS unsigned* st;
};

__device__ __forceinline__ XcdBarrier xcd_barrier_post(unsigned* bar, volatile LAS unsigned* st) {
    XcdBarrier b; b.bar = bar; b.x = xb_xcc_id(); b.st = st;
    if (threadIdx.x == 0) (void)xb_add(&bar[XB_XCNT(b.x)], 1u);
    return b;
}
__device__ __forceinline__ void xcd_barrier_complete(unsigned* bar, unsigned x, unsigned& nloc, unsigned& nx) {
    const unsigned G = gridDim.x * gridDim.y * gridDim.z;
    unsigned sum, cnt, mine, sp = 0u;
    for (;;) {
        sum = 0u; cnt = 0u; mine = 0u;
#pragma unroll
        for (unsigned j = 0; j < 16; ++j) { const unsigned c = xb_ld(&bar[XB_XCNT(j)]); sum += c; cnt += (c > 0u) ? 1u : 0u; mine = (j == x) ? c : mine; }
        if (sum == G) break;
        __builtin_amdgcn_s_sleep(1);
        if ((++sp & 255u) == 0u) { if (xb_ld(&bar[XB_TMO])) break; if (sp > XB_SPIN_CAP) { atomicAdd(&bar[XB_TMO], 1u); break; } }
    }
    nloc = mine > 0u ? mine : 1u; nx = cnt > 0u ? cnt : 1u;
}

__device__ __forceinline__ void xcd_barrier(const XcdBarrier& b) {
    asm volatile("s_waitcnt vmcnt(0)" ::: "memory");
    __syncthreads();
    if (threadIdx.x == 0) {
        unsigned* bar = b.bar;
        __builtin_amdgcn_s_waitcnt(0);
        unsigned nloc = b.st[0], nx = b.st[1];
        if (nloc == 0u) { xcd_barrier_complete(bar, b.x, nloc, nx); b.st[0] = nloc; b.st[1] = nx; }
        const unsigned old = xb_add(&bar[XB_XSUB(b.x)], 1u);
        const unsigned gen = old / nloc;
        if (old + 1u == (gen + 1u) * nloc) {
            __builtin_amdgcn_fence(__ATOMIC_RELEASE, "agent");
            asm volatile("s_waitcnt vmcnt(0)" ::: "memory");
            const unsigned og = xb_add(&bar[XB_TOP], 1u);
            const unsigned tg = og / nx;
            if (og + 1u == (tg + 1u) * nx) xb_add(&bar[XB_TOPGEN], 1u);
            else XB_SPIN(xb_ld(&bar[XB_TOPGEN]) == tg, bar);
            __builtin_amdgcn_fence(__ATOMIC_ACQUIRE, "agent");
            xb_add(&bar[XB_XGEN(b.x)], 1u);
            asm volatile("s_waitcnt vmcnt(0)" ::: "memory");
        } else {
            XB_SPIN(xb_ld(&bar[XB_XGEN(b.x)]) == gen, bar);
            __builtin_amdgcn_fence(__ATOMIC_ACQUIRE, "agent");
            asm volatile("s_waitcnt vmcnt(0)" ::: "memory");
        }
    }
    __syncthreads();
}


typedef const __attribute__((address_space(4))) Params* KPtr;
__device__ __forceinline__ Params kparams() {
#if defined(__HIP_DEVICE_COMPILE__)
    KPtr q = (KPtr)__builtin_amdgcn_kernarg_segment_ptr(); asm volatile("" : "+s"(q)); return *q;
#else
    return Params{};
#endif
}
#define PP kparams()
__global__ void __launch_bounds__(NTHR, 2) fwd_mega(Params p_unused) {
    extern __shared__ __attribute__((aligned(16))) unsigned char smem[];
    LAS unsigned char* lds = (LAS unsigned char*)smem;
    cg::grid_group grid = cg::this_grid();
    unsigned char* ws = kparams().ws;
    volatile LAS unsigned* bst = (volatile LAS unsigned*)(lds + LDS_BYTES - 16);
    if (threadIdx.x == 0) { bst[0] = 0u; bst[1] = 0u; }
    __syncthreads();
    const XcdBarrier xbar = xcd_barrier_post((unsigned*)(ws + WS_BAR), bst);
#define GSYNC() xcd_barrier(xbar)
    bf16_t* XR = (bf16_t*)(ws + WS_XR); bf16_t* H = (bf16_t*)(ws + WS_H); bf16_t* Q = (bf16_t*)(ws + WS_Q); bf16_t* YS = (bf16_t*)(ws + WS_YS);
    const float* mod = (const float*)(ws + WS_MOD);

    phase_mod(PP, (LAS float*)lds);
    convert_layer(PP, 0, (LAS float*)lds);
    grid.sync();

#pragma unroll 1
    for (int l = 0; l < 2; ++l) {
        const bool last = l == 1;
        const float* modl = mod + (size_t)l * 9 * 12288;
        const int Mrows = last ? MX : MT;
        if (l == 0) phase_norm<true>(PP.in[I_X], PP.in[I_CTX], nullptr, PP.in[I_GMIX], modl, 0, 1, H, MT);
        else { phase_norm<false>(nullptr, nullptr, XR, PP.in[I_GMIX] + D, modl, 0, 1, H, MT); convert_layer(PP, 1, (LAS float*)lds); }
        GSYNC();
        { pg8::Gemm g{H, (const bf16_t*)(ws + WS_WIN), D, 0, MT, INW, D, 8};
          pg8::EpiStore E{Q, INW, 14, (bf16_t*)(ws + WS_VT), (bf16_t*)(ws + WS_VTC)};
          pg8::gemm_phase(lds, g, E); }
        GSYNC();
        attn_tasks(PP, l, !last, lds);
        lru_tiles(PP, l, false, false, lds);
        GSYNC();
        lru_tiles(PP, l, true, last, lds);
        pool_tiles(PP, l, last, lds);
        sgu_tiles(PP, l, last, lds);
        GSYNC();
        { pg8::Gemm g{YS, (const bf16_t*)(ws + WS_WB), D, 1024, Mrows, 8192, 512, 8};
          pg8::EpiStore E{Q, 8192, 1 << 30, nullptr, nullptr};
          pg8::gemm_phase(lds, g, E); }
        GSYNC();
        { pg8::Gemm g{H, (const bf16_t*)(ws + WS_GATE), D, 0, Mrows, 8192, D, 8};
          pg8::EpiGate E{Q, YS};
          pg8::gemm_phase(lds, g, E); }
        GSYNC();
        { pg8::Gemm g{YS, (const bf16_t*)(ws + WS_WO), D, 0, Mrows, D, D, 8};
          pg8::EpiRes E{XR, modl + 2 * 2048, l == 0 ? PP.in[I_X] : nullptr, PP.in[I_CTX]};
          pg8::gemm_phase(lds, g, E); }
        GSYNC();
        phase_norm<false>(nullptr, nullptr, XR, PP.in[I_GFFN] + (size_t)l * D, modl, 3, 4, H, Mrows);
        GSYNC();
        { pg8::Gemm g{H, (const bf16_t*)(ws + WS_GU), D, 0, Mrows, 2 * DFF, D, 8};
          pg8::EpiSwi E{Q};
          pg8::gemm_phase(lds, g, E); }
        GSYNC();
        { pg8::Gemm g{Q, (const bf16_t*)(ws + WS_WD), DFF, 0, Mrows, D, DFF, 8};
          pg8::EpiRes E{XR, modl + 5 * 2048, nullptr, nullptr};
          pg8::gemm_phase(lds, g, E); }
        GSYNC();
    }
    phase_final(XR, PP.in[I_GFINAL], PP.out);
}

extern "C" void kernel_launch(void* const* d_in, const int* in_sizes, int n_in, void* d_out, int out_size, void* d_ws, size_t ws_size, hipStream_t stream) {
    static int grid = 0;
    if (grid == 0) {
        if (n_in != 29 || ws_size < WS_END) { fprintf(stderr, "kernel_launch: n_in %d ws %zu need %zu\n", n_in, ws_size, (size_t)WS_END); grid = -1; return; }
        int dev = 0, cus = 0, per_cu = 0;
        hipGetDevice(&dev);
        hipDeviceGetAttribute(&cus, hipDeviceAttributeMultiprocessorCount, dev);
        hipFuncSetAttribute((const void*)fwd_mega, hipFuncAttributeMaxDynamicSharedMemorySize, LDS_BYTES);
        hipOccupancyMaxActiveBlocksPerMultiprocessor(&per_cu, (const void*)fwd_mega, NTHR, LDS_BYTES);
        if (per_cu < 1) { fprintf(stderr, "kernel_launch: occupancy query says %d blocks/CU\n", per_cu); per_cu = 1; }
        grid = cus * 1;
        (void)hipGetLastError();
    }
    if (grid < 0) return;
    Params p{};
    for (int i = 0; i < 29; ++i) p.in[i] = (const float*)d_in[i];
    p.out = (float*)d_out; p.ws = (unsigned char*)d_ws;
    (void)hipMemsetAsync((unsigned char*)d_ws + WS_BAR, 0, 3456 * 4, stream);
    void* args[] = {&p};
    hipError_t e = hipLaunchCooperativeKernel((const void*)fwd_mega, dim3(grid), dim3(NTHR), args, LDS_BYTES, stream);
    if (e != hipSuccess) fprintf(stderr, "cooperative launch failed: %s (grid %d)\n", hipGetErrorString(e), grid);
}
```

```cpp
#include <hip/hip_runtime.h>
#include <hip/hip_cooperative_groups.h>
#include <cstdio>
#include <cstdint>
namespace cg = cooperative_groups;

#define LAS __attribute__((address_space(3)))
typedef unsigned short bf16_t;
typedef short bf16x8 __attribute__((ext_vector_type(8)));
typedef float f32x4 __attribute__((ext_vector_type(4)));
typedef unsigned u32x4 __attribute__((ext_vector_type(4)));
typedef unsigned u32x2 __attribute__((ext_vector_type(2)));

constexpr int D = 2048, NB = 8, SEQ = 2048, CTXL = 256;
constexpr int MX = NB * SEQ, MC = NB * CTXL, MT = MX + MC;
constexpr int INW = 4096, DFF = 5632;
constexpr int NTHR = 512;
constexpr int LDS_BYTES = 147456;

constexpr size_t al256(size_t x) { return (x + 255) & ~(size_t)255; }
constexpr size_t WS_MOD   = 0;
constexpr size_t WS_AGG   = al256(WS_MOD + (size_t)2 * 9 * 12288 * 4);
constexpr size_t WS_SMALL = al256(WS_AGG + (size_t)2 * 8 * 18 * 512 * 2 * 4);
constexpr size_t SMALL_L  = (size_t)24 * 16384;
constexpr size_t WS_WIN   = al256(WS_SMALL + 2 * SMALL_L * 2);
constexpr size_t WS_GATE  = al256(WS_WIN + (size_t)4096 * 2048 * 2);
constexpr size_t WS_WB    = al256(WS_GATE + (size_t)8192 * 2048 * 2);
constexpr size_t WS_WO    = al256(WS_WB + (size_t)8192 * 512 * 2);
constexpr size_t WS_GU    = al256(WS_WO + (size_t)2048 * 2048 * 2);
constexpr size_t WS_WD    = al256(WS_GU + (size_t)11264 * 2048 * 2);
constexpr size_t WS_XR    = al256(WS_WD + (size_t)2048 * 5632 * 2);
constexpr size_t WS_H     = al256(WS_XR + (size_t)MT * D * 2);
constexpr size_t WS_Q     = al256(WS_H + (size_t)MT * D * 2);
constexpr size_t WS_YS    = al256(WS_Q + (size_t)MT * 8192 * 2);
constexpr size_t WS_VT    = al256(WS_YS + (size_t)MT * D * 2);
constexpr size_t WS_VTC   = al256(WS_VT + (size_t)NB * 4 * 128 * SEQ * 2);
constexpr size_t WS_AB    = al256(WS_VTC + (size_t)NB * 4 * 128 * CTXL * 2);
constexpr size_t WS_BAR   = al256(WS_AB + (size_t)MT * 2 * 512 * 4);
constexpr size_t WS_END   = al256(WS_BAR + 3456 * 4);

struct Params { const float* in[29]; float* out; unsigned char* ws; };
enum { I_X = 0, I_C, I_CTX, I_CCTX, I_WMOD, I_BMOD, I_GMIX, I_GFFN, I_GFINAL, I_WIN, I_WPOOL, I_PSCALE, I_LNG, I_WSP, I_BSP, I_CONVW, I_CONVB,
       I_WRG, I_BRG, I_WIG, I_BIG, I_LAM, I_RPB, I_WBR, I_WGATE, I_WOUT, I_WFG, I_WFU, I_WFD };

__device__ __forceinline__ unsigned cvt_pk_bf16(float lo, float hi) { unsigned r; asm volatile("v_cvt_pk_bf16_f32 %0, %1, %2" : "=v"(r) : "v"(lo), "v"(hi)); return r; }
__device__ __forceinline__ bf16_t f2bf(float f) { return (bf16_t)(cvt_pk_bf16(f, 0.f) & 0xffffu); }
__device__ __forceinline__ float bf2f(bf16_t b) { return __uint_as_float(((unsigned)b) << 16); }
__device__ __forceinline__ float bflo(unsigned u) { return __uint_as_float(u << 16); }
__device__ __forceinline__ float bfhi(unsigned u) { return __uint_as_float(u & 0xffff0000u); }
__device__ __forceinline__ float sigm(float x) { return __builtin_amdgcn_rcpf(1.f + __builtin_amdgcn_exp2f(-1.4426950408889634f * x)); }
__device__ __forceinline__ float fexp(float x) { return __builtin_amdgcn_exp2f(1.4426950408889634f * x); }
__device__ __forceinline__ float gelu_tanh(float x) { const float u = 0.7978845608028654f * (x + 0.044715f * x * x * x); return x * sigm(2.f * u); }
__device__ __forceinline__ int otid() { int t = threadIdx.x; asm volatile("" : "+v"(t)); return t; }
__device__ __forceinline__ int obid() { int t = blockIdx.x; asm volatile("" : "+s"(t)); return t; }
__device__ __forceinline__ float wave_sum(float v) {
#pragma unroll
    for (int o = 32; o >= 1; o >>= 1) v += __shfl_xor(v, o);
    return v;
}

namespace pg8 {
constexpr int BM = 256, BK = 64, HALF = 128, HTB = HALF * BK * 2, STAGE_BYTES = 8 * HTB, NXCD = 8, WGM = 8;
__device__ __forceinline__ int lds_byte(int r, int c) { const int st = (r >> 4) * 2 + (c >> 5), rr = r & 15, cc = c & 31, ob = rr * 64 + cc * 2; return st * 1024 + (ob ^ (((ob >> 9) & 1) << 5)); }
__device__ __forceinline__ void stage_rc(int b, int& R, int& C) { const int st = b / 1024, sb = b % 1024, swz = sb ^ (((sb >> 9) & 1) << 5); R = (st >> 1) * 16 + swz / 64; C = (st & 1) * 32 + (swz % 64) / 2; }
__device__ __forceinline__ int perm32(int rho) { const int n = rho >> 4, i = rho & 15; return 8 * (i >> 2) + 4 * n + (i & 3); }

struct Unit { int pm, pn; };
struct Gemm { const bf16_t* A; const bf16_t* Bt; int lda; int a_grp_bytes; int M, N, K; int wgm; };

struct StaticOrder {
    int nM, nN, nwg, G, c, wgm;
    __device__ void init(int M, int N, int G_, int c_, int w_) { nM = M / BM; nN = N / BM; nwg = nM * nN; G = G_; c = c_; wgm = w_; }
    __device__ bool next(int i, Unit& u) const {
        const long L = (long)i * G + c; if (L >= nwg) return false;
        int wgid = (int)L; { const int q = nwg / NXCD, r = nwg % NXCD, xcd = wgid % NXCD, off = wgid / NXCD; wgid = (xcd < r ? xcd * (q + 1) : r * (q + 1) + (xcd - r) * q) + off; }
        const int nig = wgm * nN, gid = wgid / nig, fm = gid * wgm, gsz = (nM - fm) < wgm ? (nM - fm) : wgm;
        u.pm = fm + ((wgid % nig) % gsz); u.pn = (wgid % nig) / gsz; return true;
    }
};


struct EpiStore {
    static constexpr bool PERM = true;
    bf16_t* O; int ldc; int vt_pn; bf16_t* VT; bf16_t* VTC;
    __device__ __forceinline__ void operator()(const f32x4 (&acc)[2][2][4][2], const Unit& u, int wr, int wc, int fr, int fq) const {
        if (u.pn < vt_pn) {
            const int row0 = u.pm * BM + wr * 64 + fr, col0 = u.pn * BM + wc * 32 + 8 * fq;
#pragma unroll
            for (int ai = 0; ai < 2; ++ai)
#pragma unroll
                for (int m = 0; m < 4; ++m) { bf16_t* rowp = O + (size_t)(row0 + ai * HALF + m * 16) * ldc + col0;
#pragma unroll
                    for (int bj = 0; bj < 2; ++bj) { const f32x4 v0 = acc[ai][bj][m][0], v1 = acc[ai][bj][m][1];
                        u32x4 o; o[0] = cvt_pk_bf16(v0[0], v0[1]); o[1] = cvt_pk_bf16(v0[2], v0[3]); o[2] = cvt_pk_bf16(v1[0], v1[1]); o[3] = cvt_pk_bf16(v1[2], v1[3]);
                        *(u32x4*)(rowp + bj * HALF) = o; } }
        } else {
            const bool isx = u.pm < 64;
            const int b = isx ? (u.pm >> 3) : (u.pm - 64);
            const int tb = isx ? (u.pm & 7) * 256 : 0;
            const int tlen = isx ? SEQ : CTXL;
            bf16_t* base = isx ? VT : VTC;
#pragma unroll
            for (int bj = 0; bj < 2; ++bj)
#pragma unroll
                for (int n = 0; n < 2; ++n)
#pragma unroll
                    for (int j = 0; j < 4; ++j) {
                        const int hd = (u.pn - vt_pn) * BM + bj * HALF + wc * 32 + 8 * fq + 4 * n + j;
                        bf16_t* colp = base + ((size_t)b * 512 + hd) * tlen + tb + wr * 64 + fr;
#pragma unroll
                        for (int ai = 0; ai < 2; ++ai)
#pragma unroll
                            for (int m = 0; m < 4; ++m) colp[ai * HALF + m * 16] = f2bf(acc[ai][bj][m][n][j]);
                    }
        }
    }
};
struct EpiGate {
    static constexpr bool PERM = false;
    const bf16_t* P; bf16_t* O;
    __device__ __forceinline__ void operator()(const f32x4 (&acc)[2][2][4][2], const Unit& u, int wr, int wc, int fr, int fq) const {
        const int row0 = u.pm * BM + wr * 64 + fr, col = u.pn * 64 + wc * 16 + 4 * fq;
        const bf16_t* pb = P + (size_t)row0 * 8192 + col;
        u32x2 pv[2][4][4];
#pragma unroll
        for (int ai = 0; ai < 2; ++ai)
#pragma unroll
            for (int m = 0; m < 4; ++m)
#pragma unroll
                for (int br = 0; br < 4; ++br) pv[ai][m][br] = *(const u32x2*)(pb + (size_t)(ai * HALF + m * 16) * 8192 + br * 2048);
        __builtin_amdgcn_sched_barrier(0);
        f32x4 sg[2][2][4][2];
#pragma unroll
        for (int ai = 0; ai < 2; ++ai)
#pragma unroll
            for (int bj = 0; bj < 2; ++bj)
#pragma unroll
                for (int m = 0; m < 4; ++m)
#pragma unroll
                    for (int n = 0; n < 2; ++n) { const f32x4 a = acc[ai][bj][m][n]; f32x4 r; r[0] = sigm(a[0]); r[1] = sigm(a[1]); r[2] = sigm(a[2]); r[3] = sigm(a[3]); sg[ai][bj][m][n] = r; }
        __builtin_amdgcn_sched_barrier(0);
#pragma unroll
        for (int ai = 0; ai < 2; ++ai)
#pragma unroll
            for (int m = 0; m < 4; ++m) {
                const size_t row = (size_t)(row0 + ai * HALF + m * 16);
                float s0 = 0.f, s1 = 0.f, s2 = 0.f, s3 = 0.f;
#pragma unroll
                for (int bj = 0; bj < 2; ++bj)
#pragma unroll
                    for (int n = 0; n < 2; ++n) {
                        const u32x2 pq = pv[ai][m][bj * 2 + n];
                        const f32x4 a = sg[ai][bj][m][n];
                        s0 += a[0] * bflo(pq[0]); s1 += a[1] * bfhi(pq[0]); s2 += a[2] * bflo(pq[1]); s3 += a[3] * bfhi(pq[1]);
                    }
                u32x2 o; o[0] = cvt_pk_bf16(s0, s1); o[1] = cvt_pk_bf16(s2, s3);
                *(u32x2*)(O + row * 2048 + col) = o;
            }
    }
};
struct EpiRes {
    static constexpr bool PERM = true;
    bf16_t* XR; const float* gate; const float* srcx; const float* srcc;
    __device__ __forceinline__ void operator()(const f32x4 (&acc)[2][2][4][2], const Unit& u, int wr, int wc, int fr, int fq) const {
        const int brow = u.pm < 64 ? (u.pm >> 3) : 8;
        const int row0 = u.pm * BM + wr * 64 + fr, col0 = u.pn * BM + wc * 32 + 8 * fq;
        const float* gp = gate + (size_t)brow * 12288 + col0;
        f32x4 gv[2][2];
#pragma unroll
        for (int bj = 0; bj < 2; ++bj)
#pragma unroll
            for (int n = 0; n < 2; ++n) gv[bj][n] = *(const f32x4*)(gp + bj * HALF + n * 4);
        if (srcx) {
            const float* sb = u.pm < 64 ? srcx + (size_t)row0 * D : srcc + (size_t)(row0 - MX) * D;
#pragma unroll
            for (int ai = 0; ai < 2; ++ai)
#pragma unroll
                for (int m = 0; m < 4; ++m) { const size_t ro = (size_t)(ai * HALF + m * 16) * D + col0;
#pragma unroll
                    for (int bj = 0; bj < 2; ++bj) {
                        const f32x4 x0 = *(const f32x4*)(sb + ro + bj * HALF), x1 = *(const f32x4*)(sb + ro + bj * HALF + 4);
                        const f32x4 y0 = x0 + gv[bj][0] * acc[ai][bj][m][0], y1 = x1 + gv[bj][1] * acc[ai][bj][m][1];
                        u32x4 o; o[0] = cvt_pk_bf16(y0[0], y0[1]); o[1] = cvt_pk_bf16(y0[2], y0[3]); o[2] = cvt_pk_bf16(y1[0], y1[1]); o[3] = cvt_pk_bf16(y1[2], y1[3]);
                        *(u32x4*)(XR + (size_t)row0 * D + ro + bj * HALF) = o; } }
        } else {
            bf16_t* xb = XR + (size_t)row0 * D + col0;
            u32x4 xv[2][4][2];
#pragma unroll
            for (int ai = 0; ai < 2; ++ai)
#pragma unroll
                for (int m = 0; m < 4; ++m)
#pragma unroll
                    for (int bj = 0; bj < 2; ++bj) xv[ai][m][bj] = *(const u32x4*)(xb + (size_t)(ai * HALF + m * 16) * D + bj * HALF);
            __builtin_amdgcn_sched_barrier(0);
#pragma unroll
            for (int ai = 0; ai < 2; ++ai)
#pragma unroll
                for (int m = 0; m < 4; ++m)
#pragma unroll
                    for (int bj = 0; bj < 2; ++bj) {
                        const u32x4 x = xv[ai][m][bj]; const f32x4 a0 = acc[ai][bj][m][0], a1 = acc[ai][bj][m][1]; const f32x4 g0 = gv[bj][0], g1 = gv[bj][1];
                        u32x4 o;
                        o[0] = cvt_pk_bf16(bflo(x[0]) + g0[0] * a0[0], bfhi(x[0]) + g0[1] * a0[1]); o[1] = cvt_pk_bf16(bflo(x[1]) + g0[2] * a0[2], bfhi(x[1]) + g0[3] * a0[3]);
                        o[2] = cvt_pk_bf16(bflo(x[2]) + g1[0] * a1[0], bfhi(x[2]) + g1[1] * a1[1]); o[3] = cvt_pk_bf16(bflo(x[3]) + g1[2] * a1[2], bfhi(x[3]) + g1[3] * a1[3]);
                        *(u32x4*)(xb + (size_t)(ai * HALF + m * 16) * D + bj * HALF) = o;
                    }
        }
    }
};
struct EpiSwi {
    static constexpr bool PERM = true;
    bf16_t* O;
    __device__ __forceinline__ void operator()(const f32x4 (&acc)[2][2][4][2], const Unit& u, int wr, int wc, int fr, int fq) const {
        const int row0 = u.pm * BM + wr * 64 + fr, col0 = u.pn * HALF + wc * 32 + 8 * fq;
#pragma unroll
        for (int ai = 0; ai < 2; ++ai)
#pragma unroll
            for (int m = 0; m < 4; ++m) {
                float v[8];
#pragma unroll
                for (int n = 0; n < 2; ++n)
#pragma unroll
                    for (int j = 0; j < 4; ++j) { const float g = acc[ai][0][m][n][j], uu = acc[ai][1][m][n][j]; v[n * 4 + j] = g * sigm(g) * uu; }
                u32x4 o; o[0] = cvt_pk_bf16(v[0], v[1]); o[1] = cvt_pk_bf16(v[2], v[3]); o[2] = cvt_pk_bf16(v[4], v[5]); o[3] = cvt_pk_bf16(v[6], v[7]);
                *(u32x4*)(O + (size_t)(row0 + ai * HALF + m * 16) * DFF + col0) = o;
            }
    }
};

template <class Epi>
__device__ __forceinline__ void gemm_phase(LAS unsigned char* lds, const Gemm g, const Epi& E) {
    const int tid = otid(), wid = __builtin_amdgcn_readfirstlane(tid >> 6), lane = tid & 63, wr = wid >> 2, wc = wid & 3, fr = lane & 15, fq = lane >> 4;
    const int K = g.K, nt = K / BK;
    StaticOrder S; S.init(g.M, g.N, gridDim.x, obid(), g.wgm);
    unsigned voffA[2], voffB[2];
#pragma unroll
    for (int i = 0; i < 2; ++i) { int R, C; stage_rc(tid * 16 + i * 8192, R, C); const int Rb = Epi::PERM ? ((R & ~31) + perm32(R & 31)) : R;
        voffA[i] = (unsigned)(R * g.lda + C) * 2u; voffB[i] = (unsigned)(Rb * K + C) * 2u; }
    const size_t kstep = (size_t)(BK * 2);
    const size_t hstepA = (size_t)HALF * g.lda * 2, tstepA = 2 * hstepA;
    const size_t hstepB = (size_t)HALF * K * 2, tstepB = 2 * hstepB;
    const unsigned ldsw = (unsigned)wid * 1024u;
    const int aoff = lds_byte(wr * 64 + fr, fq * 8), boff = lds_byte(wc * 32 + fr, fq * 8);
#define PG8_SA(b, h) (((b) * 2 + (h)) * HTB)
#define PG8_SB(b, h) ((4 + (b) * 2 + (h)) * HTB)
#define PG8_STAGE(bufoff, gbase, voff) do { _Pragma("unroll") for (int _i = 0; _i < 2; ++_i) \
        __builtin_amdgcn_global_load_lds((const unsigned*)((const char*)(gbase) + (voff)[_i]), (LAS unsigned*)(lds + (bufoff) + ldsw + _i * 8192), 16, 0, 0); } while (0)
#define PG8_LDA(dst, b, h) do { _Pragma("unroll") for (int m = 0; m < 4; ++m) _Pragma("unroll") for (int k = 0; k < 2; ++k) dst[m][k] = *(const LAS bf16x8*)(lds + PG8_SA(b, h) + aoff + m * 2048 + k * 1024); } while (0)
#define PG8_LDB(dst, b, h) do { _Pragma("unroll") for (int n = 0; n < 2; ++n) _Pragma("unroll") for (int k = 0; k < 2; ++k) dst[n][k] = *(const LAS bf16x8*)(lds + PG8_SB(b, h) + boff + n * 2048 + k * 1024); } while (0)
#define PG8_MMA(ai, bj, At, Bt) do { __builtin_amdgcn_s_setprio(1); _Pragma("unroll") for (int m = 0; m < 4; ++m) _Pragma("unroll") for (int n = 0; n < 2; ++n) _Pragma("unroll") for (int k = 0; k < 2; ++k) \
        acc[ai][bj][m][n] = __builtin_amdgcn_mfma_f32_16x16x32_bf16(Bt[n][k], At[m][k], acc[ai][bj][m][n], 0, 0, 0); __builtin_amdgcn_s_setprio(0); } while (0)
#define PG8_WAIT_V(n) asm volatile("s_waitcnt vmcnt(" #n ")" ::: "memory")
#define PG8_WAIT_L(n) asm volatile("s_waitcnt lgkmcnt(" #n ")" ::: "memory")
#define PG8_BAR __builtin_amdgcn_s_barrier()
#define PG8_SCHED __builtin_amdgcn_sched_barrier(0)
    Unit cur, nxt; int ui = 0;
    if (!S.next(0, cur)) return;
    f32x4 acc[2][2][4][2];
#pragma unroll
    for (int a = 0; a < 2; ++a)
#pragma unroll
        for (int b = 0; b < 2; ++b)
#pragma unroll
            for (int m = 0; m < 4; ++m)
#pragma unroll
                for (int n = 0; n < 2; ++n) acc[a][b][m][n] = (f32x4){0.f, 0.f, 0.f, 0.f};
    bf16x8 At[4][2], B0[2][2], B1[2][2];
    const char* cA = (const char*)g.A + (size_t)cur.pm * tstepA + (size_t)(cur.pn >> 3) * g.a_grp_bytes; const char* cB = (const char*)g.Bt + (size_t)cur.pn * tstepB;
    PG8_STAGE(PG8_SB(0, 0), cB, voffB); PG8_STAGE(PG8_SB(0, 1), cB + hstepB, voffB); PG8_STAGE(PG8_SA(0, 0), cA, voffA); PG8_STAGE(PG8_SA(0, 1), cA + hstepA, voffA);
    if (wr == 1) PG8_BAR;
    PG8_WAIT_V(2); PG8_BAR;
    PG8_STAGE(PG8_SB(1, 0), cB + kstep, voffB); PG8_STAGE(PG8_SA(1, 0), cA + kstep, voffA); PG8_STAGE(PG8_SB(1, 1), cB + hstepB + kstep, voffB);
    PG8_WAIT_V(6); PG8_BAR;
    for (;;) {
        const bool has_next = S.next(ui + 1, nxt);
        const char* nA = has_next ? (const char*)g.A + (size_t)nxt.pm * tstepA + (size_t)(nxt.pn >> 3) * g.a_grp_bytes : cA; const char* nB = has_next ? (const char*)g.Bt + (size_t)nxt.pn * tstepB : cB;
        for (int t = 0; t < nt; t += 2) {
            const bool last = (t == nt - 2);
            const char* a1 = cA + (size_t)(t + 1) * kstep;
            const char* a2 = last ? nA : cA + (size_t)(t + 2) * kstep; const char* b2 = last ? nB : cB + (size_t)(t + 2) * kstep;
            const char* a3 = a2 + kstep; const char* b3 = b2 + kstep;
            PG8_LDB(B0, 0, 0); PG8_LDB(B1, 0, 1); PG8_SCHED; PG8_LDA(At, 0, 0); PG8_STAGE(PG8_SA(1, 1), a1 + hstepA, voffA);
            PG8_WAIT_V(8); PG8_WAIT_L(0); PG8_BAR; PG8_MMA(0, 0, At, B0); PG8_MMA(0, 1, At, B1); PG8_BAR; PG8_SCHED;
            PG8_LDA(At, 0, 1); PG8_STAGE(PG8_SB(0, 0), b2, voffB); PG8_STAGE(PG8_SB(0, 1), b2 + hstepB, voffB); PG8_STAGE(PG8_SA(0, 0), a2, voffA);
            PG8_WAIT_V(8); PG8_WAIT_L(0); PG8_BAR; PG8_MMA(1, 0, At, B0); PG8_MMA(1, 1, At, B1); PG8_BAR; PG8_SCHED;
            PG8_LDB(B0, 1, 0); PG8_LDB(B1, 1, 1); PG8_SCHED; PG8_LDA(At, 1, 0); PG8_STAGE(PG8_SA(0, 1), a2 + hstepA, voffA);
            PG8_WAIT_V(8); PG8_WAIT_L(0); PG8_BAR; PG8_MMA(0, 0, At, B0); PG8_MMA(0, 1, At, B1); PG8_BAR; PG8_SCHED;
            PG8_LDA(At, 1, 1); PG8_STAGE(PG8_SB(1, 0), b3, voffB); PG8_STAGE(PG8_SB(1, 1), b3 + hstepB, voffB); PG8_STAGE(PG8_SA(1, 0), a3, voffA);
            PG8_WAIT_V(8); PG8_WAIT_L(0); PG8_BAR; PG8_MMA(1, 0, At, B0); PG8_MMA(1, 1, At, B1); PG8_BAR; PG8_SCHED;
        }
        if (wr == 0) PG8_BAR;
        E(acc, cur, wr, wc, fr, fq);
        if (!has_next) break;
#pragma unroll
        for (int a = 0; a < 2; ++a)
#pragma unroll
            for (int b = 0; b < 2; ++b)
#pragma unroll
                for (int m = 0; m < 4; ++m)
#pragma unroll
                    for (int n = 0; n < 2; ++n) acc[a][b][m][n] = (f32x4){0.f, 0.f, 0.f, 0.f};
        cur = nxt; cA = nA; cB = nB; ++ui;
        if (wr == 1) PG8_BAR;
    }
    PG8_WAIT_V(0);
    PG8_BAR;
#undef PG8_SA
#undef PG8_SB
#undef PG8_STAGE
#undef PG8_LDA
#undef PG8_LDB
#undef PG8_MMA
#undef PG8_WAIT_V
#undef PG8_WAIT_L
#undef PG8_BAR
#undef PG8_SCHED
}
}

template <int MODE>
__device__ __forceinline__ const float* conv_src(const float* src, const float* src2, int R) {
    if (MODE == 0) return src + R;
    if (MODE == 1) { const int pn = R >> 8, rho = R & 255; const int br = ((rho >> 7) << 1) | ((rho >> 4) & 1); const int c = pn * 64 + ((rho >> 5) & 3) * 16 + (rho & 15); return src + br * 2048 + c; }
    const int pn = R >> 8, rho = R & 255; return ((rho >> 7) ? src2 : src) + pn * 128 + (rho & 127);
}
template <int MODE>
__device__ __forceinline__ void conv_T(const float* src, const float* src2, int src_ld, bf16_t* dst, int K, int NR, LAS float* lds) {
    const int tid = otid();
    const int kt = K >> 7, ntiles = (NR >> 6) * kt;
    const int rr = tid & 63, kk0 = tid >> 6, kp = tid & 15, rr0 = tid >> 4;
    float v[16];
    int tl = obid();
    if (tl < ntiles) {
        const int R0 = (tl / kt) << 6, k0 = (tl % kt) << 7;
        const float* sp = conv_src<MODE>(src, src2, R0 + rr) + (size_t)(k0 + kk0) * src_ld;
#pragma unroll
        for (int i = 0; i < 16; ++i) v[i] = sp[(size_t)(8 * i) * src_ld];
    }
    for (int it = 0; tl < ntiles; tl += gridDim.x, ++it) {
        LAS float* tile = lds + (it & 1) * (128 * 65);
#pragma unroll
        for (int i = 0; i < 16; ++i) tile[(kk0 + 8 * i) * 65 + rr] = v[i];
        const int tn = tl + gridDim.x;
        if (tn < ntiles) {
            const int R0n = (tn / kt) << 6, k0n = (tn % kt) << 7;
            const float* sp = conv_src<MODE>(src, src2, R0n + rr) + (size_t)(k0n + kk0) * src_ld;
#pragma unroll
            for (int i = 0; i < 16; ++i) v[i] = sp[(size_t)(8 * i) * src_ld];
        }
        __syncthreads();
        const int R0 = (tl / kt) << 6, k0 = (tl % kt) << 7;
#pragma unroll
        for (int i = 0; i < 2; ++i) {
            const int r = rr0 + 32 * i;
            float f[8];
#pragma unroll
            for (int j = 0; j < 8; ++j) f[j] = tile[(8 * kp + j) * 65 + r];
            u32x4 o; o[0] = cvt_pk_bf16(f[0], f[1]); o[1] = cvt_pk_bf16(f[2], f[3]); o[2] = cvt_pk_bf16(f[4], f[5]); o[3] = cvt_pk_bf16(f[6], f[7]);
            *(u32x4*)(dst + (size_t)(R0 + r) * K + k0 + 8 * kp) = o;
        }
    }
    __syncthreads();
}

__device__ void convert_layer(const Params& p, int l, LAS float* tile) {
    unsigned char* ws = p.ws;
    conv_T<0>(p.in[I_WIN] + (size_t)l * D * INW, nullptr, INW, (bf16_t*)(ws + WS_WIN), D, INW, tile);
    conv_T<1>(p.in[I_WGATE] + (size_t)l * D * 8192, nullptr, 8192, (bf16_t*)(ws + WS_GATE), D, 8192, tile);
    for (int n = 0; n < 4; ++n)
        conv_T<0>(p.in[I_WBR] + ((size_t)l * 4 + n) * 512 * D, nullptr, D, (bf16_t*)(ws + WS_WB) + (size_t)n * 2048 * 512, 512, D, tile);
    conv_T<0>(p.in[I_WOUT] + (size_t)l * D * D, nullptr, D, (bf16_t*)(ws + WS_WO), D, D, tile);
    conv_T<2>(p.in[I_WFG] + (size_t)l * D * DFF, p.in[I_WFU] + (size_t)l * D * DFF, DFF, (bf16_t*)(ws + WS_GU), D, 2 * DFF, tile);
    conv_T<0>(p.in[I_WFD] + (size_t)l * DFF * D, nullptr, D, (bf16_t*)(ws + WS_WD), DFF, D, tile);
    bf16_t* sm = (bf16_t*)(ws + WS_SMALL) + (size_t)l * SMALL_L;
    for (int gI = 0; gI < 4; ++gI) conv_T<0>(p.in[I_WPOOL] + ((size_t)l * 4 + gI) * 16384, nullptr, 128, sm + (size_t)gI * 16384, 128, 128, tile);
    for (int gI = 0; gI < 8; ++gI) conv_T<0>(p.in[I_WRG] + ((size_t)l * 8 + gI) * 16384, nullptr, 128, sm + (size_t)(4 + gI) * 16384, 128, 128, tile);
    for (int gI = 0; gI < 8; ++gI) conv_T<0>(p.in[I_WIG] + ((size_t)l * 8 + gI) * 16384, nullptr, 128, sm + (size_t)(12 + gI) * 16384, 128, 128, tile);
    {
        const float* s = p.in[I_WSP] + (size_t)l * 65536; bf16_t* d = sm + (size_t)20 * 16384;
        for (int i = obid() * NTHR + otid(); i < 32768; i += gridDim.x * NTHR) *(unsigned*)(d + 2 * i) = cvt_pk_bf16(s[2 * i], s[2 * i + 1]);
    }
}

__device__ void phase_mod(const Params& p, LAS float* lds) {
    const int tid = otid();
    LAS float* cond = lds; LAS float* red = lds + 9 * 2048;
    for (int i = tid; i < 9 * 2048; i += NTHR) { const int r = i >> 11, k = i & 2047; const float v = r < 8 ? p.in[I_C][r * 2048 + k] : p.in[I_CCTX][k]; cond[i] = v * sigm(v); }
    __syncthreads();
    float* mod = (float*)(p.ws + WS_MOD);
    for (int chunk = obid(); chunk < 256; chunk += gridDim.x) {
        const int l = chunk >> 7, col0 = (chunk & 127) * 96;
        const float* W = p.in[I_WMOD] + (size_t)l * 2048 * 12288;
        if (tid < 384) {
            const int q = tid % 24, kg = tid / 24;
            float acc[9][4];
#pragma unroll
            for (int r = 0; r < 9; ++r)
#pragma unroll
                for (int j = 0; j < 4; ++j) acc[r][j] = 0.f;
            const float* wp = W + (size_t)(kg * 128) * 12288 + col0 + 4 * q;
#pragma unroll 8
            for (int kk = 0; kk < 128; ++kk) {
                const f32x4 w = *(const f32x4*)(wp + (size_t)kk * 12288);
#pragma unroll
                for (int r = 0; r < 9; ++r) { const float cv = cond[r * 2048 + kg * 128 + kk];
#pragma unroll
                    for (int j = 0; j < 4; ++j) acc[r][j] += cv * w[j]; }
            }
#pragma unroll
            for (int r = 0; r < 9; ++r)
#pragma unroll
                for (int j = 0; j < 4; ++j) red[kg * 864 + q * 36 + r * 4 + j] = acc[r][j];
        }
        __syncthreads();
        for (int o = tid; o < 864; o += NTHR) {
            const int r = o / 96, cc = o % 96, q = cc >> 2, j = cc & 3;
            float s = p.in[I_BMOD][l * 12288 + col0 + cc];
#pragma unroll
            for (int kg = 0; kg < 16; ++kg) s += red[kg * 864 + q * 36 + r * 4 + j];
            mod[((size_t)l * 9 + r) * 12288 + col0 + cc] = s;
        }
        __syncthreads();
    }
}

template <bool F32SRC>
__device__ void phase_norm(const float* xsrc, const float* csrc, const bf16_t* XRb, const float* gamma, const float* modl, int shi, int sci, bf16_t* H, int nrows) {
    const int tid_ = otid(); const int lane = tid_ & 63, gw = obid() * 8 + (tid_ >> 6), nw = gridDim.x * 8;
    for (int row = gw; row < nrows; row += nw) {
        const int brow = row < MX ? (row >> 11) : 8;
        float v[32]; float ss = 0.f;
        if (F32SRC) {
            const float* src = row < MX ? xsrc + (size_t)row * D : csrc + (size_t)(row - MX) * D;
#pragma unroll
            for (int i = 0; i < 4; ++i) { const f32x4 a = *(const f32x4*)(src + 8 * (lane + 64 * i)), b = *(const f32x4*)(src + 8 * (lane + 64 * i) + 4);
#pragma unroll
                for (int j = 0; j < 4; ++j) { v[8 * i + j] = a[j]; v[8 * i + 4 + j] = b[j]; } }
        } else {
#pragma unroll
            for (int i = 0; i < 4; ++i) { const u32x4 a = *(const u32x4*)(XRb + (size_t)row * D + 8 * (lane + 64 * i));
#pragma unroll
                for (int j = 0; j < 4; ++j) { v[8 * i + 2 * j] = bflo(a[j]); v[8 * i + 2 * j + 1] = bfhi(a[j]); } }
        }
#pragma unroll
        for (int i = 0; i < 32; ++i) ss += v[i] * v[i];
        ss = wave_sum(ss);
        const float rstd = rsqrtf(ss * (1.f / D) + 1e-6f);
        const float* shp = modl + (size_t)brow * 12288 + shi * 2048; const float* scp = modl + (size_t)brow * 12288 + sci * 2048;
#pragma unroll
        for (int i = 0; i < 4; ++i) {
            const int col = 8 * (lane + 64 * i);
            float y[8];
#pragma unroll
            for (int hh = 0; hh < 2; ++hh) { const f32x4 g = *(const f32x4*)(gamma + col + 4 * hh), sc = *(const f32x4*)(scp + col + 4 * hh), sh = *(const f32x4*)(shp + col + 4 * hh);
#pragma unroll
                for (int j = 0; j < 4; ++j) y[4 * hh + j] = v[8 * i + 4 * hh + j] * rstd * g[j] * (1.f + sc[j]) + sh[j]; }
            u32x4 o; o[0] = cvt_pk_bf16(y[0], y[1]); o[1] = cvt_pk_bf16(y[2], y[3]); o[2] = cvt_pk_bf16(y[4], y[5]); o[3] = cvt_pk_bf16(y[6], y[7]);
            *(u32x4*)(H + (size_t)row * D + col) = o;
        }
    }
}
__device__ void phase_final(const bf16_t* XRb, const float* gamma, float* out) {
    const int tid_ = otid(); const int lane = tid_ & 63, gw = obid() * 8 + (tid_ >> 6), nw = gridDim.x * 8;
    for (int row = gw; row < MX; row += nw) {
        float v[32]; float ss = 0.f;
#pragma unroll
        for (int i = 0; i < 4; ++i) { const u32x4 a = *(const u32x4*)(XRb + (size_t)row * D + 8 * (lane + 64 * i));
#pragma unroll
            for (int j = 0; j < 4; ++j) { v[8 * i + 2 * j] = bflo(a[j]); v[8 * i + 2 * j + 1] = bfhi(a[j]); } }
#pragma unroll
        for (int i = 0; i < 32; ++i) ss += v[i] * v[i];
        ss = wave_sum(ss);
        const float rstd = rsqrtf(ss * (1.f / D) + 1e-6f);
#pragma unroll
        for (int i = 0; i < 4; ++i) { const int col = 8 * (lane + 64 * i);
#pragma unroll
            for (int hh = 0; hh < 2; ++hh) { const f32x4 g = *(const f32x4*)(gamma + col + 4 * hh); f32x4 y;
#pragma unroll
                for (int j = 0; j < 4; ++j) y[j] = v[8 * i + 4 * hh + j] * rstd * g[j];
                *(f32x4*)(out + (size_t)row * D + col + 4 * hh) = y; } }
    }
}

constexpr int LDT = 136;
constexpr int L_X = 0, L_Y1 = 34816, L_Y2 = 69632, L_MISC = 110592;

__device__ __forceinline__ void mm128(const LAS bf16_t* X, const LAS bf16_t* Y, int w, int lr, int quad, f32x4 (&acc)[8]) {
#pragma unroll
    for (int kk = 0; kk < 4; ++kk) {
        const bf16x8 a = *(const LAS bf16x8*)(X + (16 * w + lr) * LDT + kk * 32 + quad * 8);
#pragma unroll
        for (int jt = 0; jt < 8; ++jt) {
            const bf16x8 b = *(const LAS bf16x8*)(Y + (16 * jt + lr) * LDT + kk * 32 + quad * 8);
            acc[jt] = __builtin_amdgcn_mfma_f32_16x16x32_bf16(a, b, acc[jt], 0, 0, 0);
        }
    }
}
__device__ __forceinline__ void mm128T(const LAS bf16_t* X, const LAS bf16_t* Y, int w, int lr, int quad, f32x4 (&acc)[8]) {
#pragma unroll
    for (int kk = 0; kk < 4; ++kk) {
        const bf16x8 a = *(const LAS bf16x8*)(X + (16 * w + lr) * LDT + kk * 32 + quad * 8);
#pragma unroll
        for (int jt = 0; jt < 8; ++jt) {
            const bf16x8 b = *(const LAS bf16x8*)(Y + (16 * jt + lr) * LDT + kk * 32 + quad * 8);
            acc[jt] = __builtin_amdgcn_mfma_f32_16x16x32_bf16(b, a, acc[jt], 0, 0, 0);
        }
    }
}
__device__ __forceinline__ void load_w128(const bf16_t* src, LAS bf16_t* dst) {
    const int tid0 = otid();
#pragma unroll
    for (int i = 0; i < 4; ++i) { const int idx = tid0 + NTHR * i; const int row = idx >> 4, c8 = (idx & 15) * 8;
        *(LAS u32x4*)(dst + row * LDT + c8) = *(const u32x4*)(src + row * 128 + c8); }
}
__device__ __forceinline__ void tile_seq(int slot, int b, int& seqrow0, int& L, int& t0) {
    if (slot < 2) { seqrow0 = MX + b * CTXL; L = CTXL; t0 = slot * 128; } else { seqrow0 = b * SEQ; L = SEQ; t0 = (slot - 2) * 128; }
}

__device__ void lru_tiles(const Params& p, int l, bool final_mode, bool skip_ctx, LAS unsigned char* lds) {
    const int rot = final_mode ? 0 : 24;
    const int tid = otid(), w = tid >> 6, lane = tid & 63, lr = lane & 15, quad = lane >> 4;
    const bf16_t* XIN = (const bf16_t*)(p.ws + WS_Q); bf16_t* YS = (bf16_t*)(p.ws + WS_YS);
    float* AGG = (float*)(p.ws + WS_AGG); unsigned* AB = (unsigned*)(p.ws + WS_AB);
    const bf16_t* sm = (const bf16_t*)(p.ws + WS_SMALL) + (size_t)l * SMALL_L;
    LAS bf16_t* X = (LAS bf16_t*)(lds + L_X);
    LAS float* hst = (LAS float*)(lds + L_MISC);
    const float* convw = p.in[I_CONVW] + (size_t)l * 4 * 512; const float* convb = p.in[I_CONVB] + (size_t)l * 512;
    const int chl = 16 * w + lr;
    const int xb = obid() & 7, xs = obid() >> 3, xn = max((int)gridDim.x >> 3, 1);
    for (int lt = (xs + rot) % xn; lt < 72; lt += xn) {
        const int tile = xb * 72 + lt;
        const int g = tile & 3, slot = (tile >> 2) % 18, b = tile / 72;
        if (skip_ctx && slot < 2) continue;
        int seqrow0, L, t0; tile_seq(slot, b, seqrow0, L, t0);
        const int ch = g * 128 + chl;
        if (!final_mode) {
            const int t = tid >> 2, part = tid & 3;
#pragma unroll
            for (int c8i = 0; c8i < 4; ++c8i) {
                const int c = part * 32 + c8i * 8, chc = g * 128 + c;
                float o[8];
                { const f32x4 b0 = *(const f32x4*)(convb + chc), b1 = *(const f32x4*)(convb + chc + 4);
#pragma unroll
                  for (int j = 0; j < 4; ++j) { o[j] = b0[j]; o[4 + j] = b1[j]; } }
#pragma unroll
                for (int k = 0; k < 4; ++k) {
                    const int tt = t0 + t + k - 2;
                    const bool okk = tt >= 0 && tt < L;
                    const int ttc = okk ? tt : t0 + t;
                    u32x4 zv = *(const u32x4*)(XIN + (size_t)(seqrow0 + ttc) * INW + 1536 + chc);
                    if (!okk) zv = (u32x4){0u, 0u, 0u, 0u};
                    const f32x4 w0 = *(const f32x4*)(convw + k * 512 + chc), w1 = *(const f32x4*)(convw + k * 512 + chc + 4);
                    o[0] += w0[0] * bflo(zv[0]); o[1] += w0[1] * bfhi(zv[0]); o[2] += w0[2] * bflo(zv[1]); o[3] += w0[3] * bfhi(zv[1]);
                    o[4] += w1[0] * bflo(zv[2]); o[5] += w1[1] * bfhi(zv[2]); o[6] += w1[2] * bflo(zv[3]); o[7] += w1[3] * bfhi(zv[3]);
                }
                u32x4 ov; ov[0] = cvt_pk_bf16(o[0], o[1]); ov[1] = cvt_pk_bf16(o[2], o[3]); ov[2] = cvt_pk_bf16(o[4], o[5]); ov[3] = cvt_pk_bf16(o[6], o[7]);
                *(LAS u32x4*)(X + t * LDT + c) = ov;
            }
        }
        if (final_mode && tid < 256) {
            const int dir = tid >> 7, chq = tid & 127;
            const float* ag = AGG + (((size_t)dir * 8 + b) * 18) * 1024 + (g * 128 + chq) * 2;
            float Ag[18], Bg[18];
#pragma unroll
            for (int s2 = 0; s2 < 18; ++s2) { Ag[s2] = ag[s2 * 1024]; Bg[s2] = ag[s2 * 1024 + 1]; }
            float h = 0.f;
            if (dir == 0) {
#pragma unroll
                for (int s2 = 0; s2 < 18; ++s2) if (s2 < slot) h = h * Ag[s2] + Bg[s2];
            } else {
                const int pos = slot == 1 ? 0 : (slot == 0 ? 1 : 19 - slot);
#pragma unroll
                for (int i = 0; i < 18; ++i) { const int s2 = i == 0 ? 1 : (i == 1 ? 0 : 19 - i); if (i < pos) h = h * Ag[s2] + Bg[s2]; }
            }
            hst[dir * 128 + chq] = h;
        }
        __syncthreads();
        f32x4 hsum[8];
#pragma unroll
        for (int rt = 0; rt < 8; ++rt) hsum[rt] = (f32x4){0.f, 0.f, 0.f, 0.f};
        const size_t abrow = (size_t)((seqrow0 + t0 + 4 * quad) >> 2);
        if (!final_mode) {
            bf16x8 bw[4][4];
#pragma unroll
            for (int mt = 0; mt < 4; ++mt) {
                const bf16_t* wp_ = sm + (size_t)(((mt & 1) ? 12 : 4) + (mt >> 1) * 4 + g) * 16384 + chl * 128 + 8 * quad;
#pragma unroll
                for (int kk = 0; kk < 4; ++kk) bw[mt][kk] = *(const bf16x8*)(wp_ + 32 * kk);
            }
            float brg[2], big[2], sp[2];
#pragma unroll
            for (int dir = 0; dir < 2; ++dir) {
                brg[dir] = p.in[I_BRG][(l * 2 + dir) * 512 + ch]; big[dir] = p.in[I_BIG][(l * 2 + dir) * 512 + ch];
                const float lam = p.in[I_LAM][(l * 2 + dir) * 512 + ch];
                sp[dir] = (lam < -15.f) ? -lam : __logf(1.f + __expf(-lam));
            }
            float fA[2][8], fB[2][8];
#pragma unroll
            for (int rt = 0; rt < 8; ++rt) {
                f32x4 acc4[4];
#pragma unroll
                for (int mt = 0; mt < 4; ++mt) acc4[mt] = (f32x4){0.f, 0.f, 0.f, 0.f};
#pragma unroll
                for (int kk = 0; kk < 4; ++kk) {
                    const bf16x8 xa = *(const LAS bf16x8*)(X + (16 * rt + lr) * LDT + kk * 32 + quad * 8);
#pragma unroll
                    for (int mt = 0; mt < 4; ++mt) acc4[mt] = __builtin_amdgcn_mfma_f32_16x16x32_bf16(xa, bw[mt][kk], acc4[mt], 0, 0, 0);
                }
                float z[4];
#pragma unroll
                for (int jj = 0; jj < 4; ++jj) z[jj] = bf2f(X[(16 * rt + 4 * quad + jj) * LDT + chl]);
#pragma unroll
                for (int dir = 0; dir < 2; ++dir) {
                    float ea[4], bv[4]; u32x4 wv;
#pragma unroll
                    for (int jj = 0; jj < 4; ++jj) {
                        const float rr = sigm(acc4[2 * dir][jj] + brg[dir]), ii = sigm(acc4[2 * dir + 1][jj] + big[dir]);
                        const unsigned lab = cvt_pk_bf16(-8.f * rr * sp[dir], 0.f) & 0xffffu;
                        const float la = bflo(lab);
                        const float x2 = 2.f * la, e_ = fexp(la);
                        const float omp = -x2 * (1.f + x2 * (0.5f + x2 * (0.16666667f + x2 * 0.041666668f))), oma = 1.f - e_ * e_;
                        const float om = oma + (omp - oma) * ((x2 > -0.125f) ? 1.f : 0.f);
                        const unsigned pw = cvt_pk_bf16(la, __builtin_amdgcn_sqrtf(om) * (ii * z[jj]));
                        ea[jj] = e_; bv[jj] = bfhi(pw); wv[jj] = pw;
                    }
                    *(u32x4*)(AB + (((size_t)dir * (MT / 4) + abrow + 4 * rt) * 512 + ch) * 4) = wv;
                    float A, Bv;
                    if (dir == 0) { A = ea[0]; Bv = bv[0];
#pragma unroll
                        for (int jj = 1; jj < 4; ++jj) { Bv = Bv * ea[jj] + bv[jj]; A *= ea[jj]; } }
                    else { A = ea[3]; Bv = bv[3];
#pragma unroll
                        for (int jj = 2; jj >= 0; --jj) { Bv = Bv * ea[jj] + bv[jj]; A *= ea[jj]; } }
                    fA[dir][rt] = A; fB[dir][rt] = Bv;
                }
            }
#pragma unroll
            for (int dir = 0; dir < 2; ++dir) {
                float Arun = 1.f, Brun = 0.f;
#pragma unroll
                for (int s1 = 0; s1 < 8; ++s1) {
                    const int rt = dir ? 7 - s1 : s1;
                    float At = 1.f, Bt = 0.f;
#pragma unroll
                    for (int s2 = 0; s2 < 4; ++s2) {
                        const int qq = dir ? 3 - s2 : s2;
                        const float Ao = __shfl(fA[dir][rt], lr + 16 * qq), Bo = __shfl(fB[dir][rt], lr + 16 * qq);
                        Bt = Bt * Ao + Bo; At *= Ao;
                    }
                    Brun = Brun * At + Bt; Arun *= At;
                }
                if (quad == 0) { float* ag = AGG + ((((size_t)dir * 8 + b) * 18 + slot) * 512 + ch) * 2; ag[0] = Arun; ag[1] = Brun; }
            }
        } else {
#pragma unroll 1
        for (int dir = 0; dir < 2; ++dir) {
            const bool rev = dir == 1;
            f32x4 a[8], bb[8];
            {
                u32x4 raw[8];
#pragma unroll
                for (int rt = 0; rt < 8; ++rt) raw[rt] = *(const u32x4*)(AB + (((size_t)dir * (MT / 4) + abrow + 4 * rt) * 512 + ch) * 4);
#pragma unroll
                for (int rt = 0; rt < 8; ++rt)
#pragma unroll
                    for (int jj = 0; jj < 4; ++jj) { a[rt][jj] = fexp(bflo(raw[rt][jj])); bb[rt][jj] = bfhi(raw[rt][jj]); }
            }
            float h = hst[dir * 128 + chl];
#pragma unroll
            for (int s1 = 0; s1 < 8; ++s1) {
                const int rt = rev ? 7 - s1 : s1;
                float A, Bv;
                if (!rev) { A = a[rt][0]; Bv = bb[rt][0];
#pragma unroll
                    for (int jj = 1; jj < 4; ++jj) { Bv = Bv * a[rt][jj] + bb[rt][jj]; A *= a[rt][jj]; } }
                else { A = a[rt][3]; Bv = bb[rt][3];
#pragma unroll
                    for (int jj = 2; jj >= 0; --jj) { Bv = Bv * a[rt][jj] + bb[rt][jj]; A *= a[rt][jj]; } }
                float Ap = 1.f, Bp = 0.f, At = 1.f, Bt = 0.f;
#pragma unroll
                for (int s2 = 0; s2 < 4; ++s2) {
                    const int qq = rev ? 3 - s2 : s2;
                    const float Ao = __shfl(A, lr + 16 * qq), Bo = __shfl(Bv, lr + 16 * qq);
                    const bool before = rev ? (qq > quad) : (qq < quad);
                    if (before) { Bp = Bp * Ao + Bo; Ap *= Ao; }
                    Bt = Bt * Ao + Bo; At *= Ao;
                }
                float hh = h * Ap + Bp;
                if (!rev) {
#pragma unroll
                    for (int jj = 0; jj < 4; ++jj) { hh = a[rt][jj] * hh + bb[rt][jj]; hsum[rt][jj] += hh; } }
                else {
#pragma unroll
                    for (int jj = 3; jj >= 0; --jj) { hh = a[rt][jj] * hh + bb[rt][jj]; hsum[rt][jj] += hh; } }
                h = h * At + Bt;
            }
        }
        }
        if (final_mode) {
#pragma unroll
            for (int rt = 0; rt < 8; ++rt)
#pragma unroll
                for (int jj = 0; jj < 4; ++jj) {
                    const size_t row = (size_t)seqrow0 + t0 + 16 * rt + 4 * quad + jj;
                    const float lg = bf2f(XIN[row * INW + 2048 + ch]);
                    YS[row * D + 1024 + ch] = f2bf(hsum[rt][jj] * gelu_tanh(lg));
                }
        }
        __syncthreads();
    }
}

__device__ void pool_tiles(const Params& p, int l, bool skip_ctx, LAS unsigned char* lds) {
    const int tid = otid(), w = tid >> 6, lane = tid & 63, lr = lane & 15, quad = lane >> 4;
    const bf16_t* XIN = (const bf16_t*)(p.ws + WS_Q); bf16_t* YS = (bf16_t*)(p.ws + WS_YS);
    const bf16_t* sm = (const bf16_t*)(p.ws + WS_SMALL) + (size_t)l * SMALL_L;
    LAS bf16_t* X = (LAS bf16_t*)(lds + L_X); LAS bf16_t* Y1 = (LAS bf16_t*)(lds + L_Y1); LAS bf16_t* ZS = (LAS bf16_t*)(lds + L_Y2);
    const int xb = obid() & 7, xs = obid() >> 3, xn = max((int)gridDim.x >> 3, 1);
    for (int lt = (xs + 24) % xn; lt < 72; lt += xn) {
        const int tile = xb * 72 + lt;
        const int g = tile & 3, slot = (tile >> 2) % 18, b = tile / 72;
        if (skip_ctx && slot < 2) continue;
        int seqrow0, L, t0; tile_seq(slot, b, seqrow0, L, t0);
        const int half = 1 << g;
        load_w128(sm + (size_t)g * 16384, Y1);
        for (int idx = tid; idx < 144 * 16; idx += NTHR) {
            const int rrow = idx >> 4, c8 = (idx & 15) * 8, tt = t0 - 8 + rrow;
            u32x4 v = (u32x4){0u, 0u, 0u, 0u};
            if (tt >= 0 && tt < L) v = *(const u32x4*)(XIN + (size_t)(seqrow0 + tt) * INW + g * 128 + c8);
            *(LAS u32x4*)(ZS + rrow * LDT + c8) = v;
        }
        __syncthreads();
        {
            const int t = tid >> 2, part = tid & 3, tt = t0 + t;
            const int lo = max(tt - half, 0), hi = min(tt + half, L);
            const float inv = 1.f / (float)(hi - lo);
#pragma unroll
            for (int c8i = 0; c8i < 4; ++c8i) {
                const int c = part * 32 + c8i * 8;
                float s[8];
#pragma unroll
                for (int j = 0; j < 8; ++j) s[j] = 0.f;
                for (int q = lo; q < hi; ++q) {
                    const u32x4 v = *(const LAS u32x4*)(ZS + (q - t0 + 8) * LDT + c);
#pragma unroll
                    for (int j = 0; j < 4; ++j) { s[2 * j] += bflo(v[j]); s[2 * j + 1] += bfhi(v[j]); }
                }
                const u32x4 zc = *(const LAS u32x4*)(ZS + (t + 8) * LDT + c);
#pragma unroll
                for (int j = 0; j < 4; ++j) { s[2 * j] = s[2 * j] * inv - bflo(zc[j]); s[2 * j + 1] = s[2 * j + 1] * inv - bfhi(zc[j]); }
                u32x4 ov; ov[0] = cvt_pk_bf16(s[0], s[1]); ov[1] = cvt_pk_bf16(s[2], s[3]); ov[2] = cvt_pk_bf16(s[4], s[5]); ov[3] = cvt_pk_bf16(s[6], s[7]);
                *(LAS u32x4*)(X + t * LDT + c) = ov;
            }
        }
        __syncthreads();
        f32x4 acc[8];
#pragma unroll
        for (int jt = 0; jt < 8; ++jt) acc[jt] = (f32x4){0.f, 0.f, 0.f, 0.f};
        mm128T(X, Y1, w, lr, quad, acc);
        {
            const size_t row = (size_t)seqrow0 + t0 + 16 * w + lr;
#pragma unroll
            for (int jt = 0; jt < 8; ++jt) {
                const int ch = g * 128 + 16 * jt + 4 * quad; const f32x4 ps = *(const f32x4*)(p.in[I_PSCALE] + l * 512 + ch);
                u32x2 o; o[0] = cvt_pk_bf16(acc[jt][0] * ps[0], acc[jt][1] * ps[1]); o[1] = cvt_pk_bf16(acc[jt][2] * ps[2], acc[jt][3] * ps[3]);
                *(u32x2*)(YS + row * D + ch) = o;
            }
        }
        __syncthreads();
    }
}

constexpr int SG_LD = 184;
__device__ void sgu_tiles(const Params& p, int l, bool skip_ctx, LAS unsigned char* lds) {
    const int tid = otid(), w = tid >> 6, lane = tid & 63, lr = lane & 15, quad = lane >> 4;
    const bf16_t* XIN = (const bf16_t*)(p.ws + WS_Q); bf16_t* YS = (bf16_t*)(p.ws + WS_YS);
    const bf16_t* sm = (const bf16_t*)(p.ws + WS_SMALL) + (size_t)l * SMALL_L;
    LAS bf16_t* X = (LAS bf16_t*)(lds + L_X); LAS bf16_t* Y1 = (LAS bf16_t*)(lds + L_Y1);
    const int xb = obid() & 7, xs = obid() >> 3, xn = max((int)gridDim.x >> 3, 1);
    for (int lt = (xs + 16) % xn; lt < 72; lt += xn) {
        const int tile = xb * 72 + lt;
        const int g = tile & 3, slot = (tile >> 2) % 18, b = tile / 72;
        if (skip_ctx && slot < 2) continue;
        int seqrow0, L, t0; tile_seq(slot, b, seqrow0, L, t0);
        load_w128(sm + (size_t)(20 + g) * 16384, X);
        {
            const int t = tid >> 2, part = tid & 3;
            const bf16_t* vrow = XIN + (size_t)(seqrow0 + t0 + t) * INW + 1024;
            float s1 = 0.f, s2 = 0.f;
#pragma unroll
            for (int i = 0; i < 16; ++i) { const u32x4 v = *(const u32x4*)(vrow + part * 128 + i * 8);
#pragma unroll
                for (int j = 0; j < 4; ++j) { const float x0 = bflo(v[j]), x1 = bfhi(v[j]); s1 += x0 + x1; s2 += x0 * x0 + x1 * x1; } }
            s1 += __shfl_xor(s1, 1); s2 += __shfl_xor(s2, 1); s1 += __shfl_xor(s1, 2); s2 += __shfl_xor(s2, 2);
            const float mean = s1 * (1.f / 512.f); const float var = fmaxf(s2 * (1.f / 512.f) - mean * mean, 0.f);
            const float rstd = rsqrtf(var + 1e-6f);
#pragma unroll
            for (int i = 0; i < 4; ++i) {
                const int c = part * 32 + i * 8;
                const u32x4 v = *(const u32x4*)(vrow + g * 128 + c);
                const float* lg = p.in[I_LNG] + l * 512 + g * 128 + c;
#pragma unroll
                for (int j = 0; j < 4; ++j) {
                    Y1[(c + 2 * j) * SG_LD + part * 16 + t] = f2bf((bflo(v[j]) - mean) * rstd * lg[2 * j]);
                    Y1[(c + 2 * j + 1) * SG_LD + part * 16 + t] = f2bf((bfhi(v[j]) - mean) * rstd * lg[2 * j + 1]);
                }
            }
        }
        __syncthreads();
        f32x4 acc[8];
#pragma unroll
        for (int jt = 0; jt < 8; ++jt) acc[jt] = (f32x4){0.f, 0.f, 0.f, 0.f};
#pragma unroll
        for (int kk = 0; kk < 4; ++kk) {
            const bf16x8 a = *(const LAS bf16x8*)(X + (16 * w + lr) * LDT + kk * 32 + quad * 8);
#pragma unroll
            for (int jt = 0; jt < 8; ++jt) {
                const int r = 16 * jt + lr;
                const bf16x8 b2 = *(const LAS bf16x8*)(Y1 + r * SG_LD + (r >> 5) * 16 + kk * 32 + quad * 8);
                acc[jt] = __builtin_amdgcn_mfma_f32_16x16x32_bf16(b2, a, acc[jt], 0, 0, 0);
            }
        }
        {
            const int pp = 16 * w + lr; const float bs = p.in[I_BSP][(l * 4 + g) * 128 + pp];
            const size_t row = (size_t)seqrow0 + t0 + pp;
#pragma unroll
            for (int jt = 0; jt < 8; ++jt) {
                const int ch = g * 128 + 16 * jt + 4 * quad;
                const u32x2 uv = *(const u32x2*)(XIN + row * INW + 512 + ch);
                u32x2 o; o[0] = cvt_pk_bf16(bflo(uv[0]) * (acc[jt][0] + bs), bfhi(uv[0]) * (acc[jt][1] + bs)); o[1] = cvt_pk_bf16(bflo(uv[1]) * (acc[jt][2] + bs), bfhi(uv[1]) * (acc[jt][3] + bs));
                *(u32x2*)(YS + row * D + 512 + ch) = o;
            }
        }
        __syncthreads();
    }
}

constexpr int AK_LD = 136, AV_LD = 72, A_SLOT = 64 * AK_LD * 2 + 128 * AV_LD * 2;
__device__ void attn_tasks(const Params& p, int l, bool with_ctx, LAS unsigned char* lds) {
    const int tid = otid(), w = tid >> 6, lane = tid & 63, lr = lane & 15, quad = lane >> 4;
    const bf16_t* XIN = (const bf16_t*)(p.ws + WS_Q); bf16_t* YS = (bf16_t*)(p.ws + WS_YS);
    const bf16_t* VT = (const bf16_t*)(p.ws + WS_VT); const bf16_t* VTC = (const bf16_t*)(p.ws + WS_VTC);
    const float scale = 0.08838834764831845f;
    const int ntask = 512 + (with_ctx ? 64 : 0);
    LAS float* rpbs = (LAS float*)(lds + L_MISC + 12288);
    for (int i = tid; i < 4 * 465; i += NTHR) rpbs[i] = p.in[I_RPB][(size_t)l * 4 * 465 + i];
    __syncthreads();
    const int krow_t = tid >> 3, kcol_t = (tid & 7) * 16, vrow_t = tid >> 2, vcol_t = (tid & 3) * 16;
    const int xb = obid() & 7, xs = obid() >> 3, xn = max((int)gridDim.x >> 3, 1);
    for (int lt = xs; lt < 64 + (with_ctx ? 8 : 0); lt += xn) {
        const int task = lt < 64 ? xb * 64 + lt : 512 + xb * 8 + (lt - 64);
        const bool isx = task < 512;
        int b, h, r0 = 0, nloc = 0, krow0 = 0, half = 0;
        if (isx) { b = task >> 6; h = (task >> 4) & 3; r0 = (task & 15) * 2; const int rsa = min(max(r0 - 4, 0), 24), rsb = min(max(r0 - 3, 0), 24); krow0 = rsa; nloc = rsb + 8 - rsa; }
        else { const int tc = task - 512; b = tc >> 3; h = (tc >> 1) & 3; half = tc & 1; }
        const int T = nloc + 4;
        const int rq = r0 + (w >> 2), j = w & 3;
        const int qrow0 = isx ? (b * SEQ + rq * 64 + 16 * j) : (MX + b * CTXL + half * 128 + 16 * w);
        const int rs = min(max(rq - 4, 0), 24);
        const int wsc = j == 0 ? 0 : (j == 1 ? 8 : (j == 2 ? 24 : 32));
        const int cq = 16 * j + lr, cs = min(max(cq - 8, 0), 48);
        const LAS float* rpb = rpbs + h * 465;
        bf16x8 qf[4];
#pragma unroll
        for (int kk = 0; kk < 4; ++kk) qf[kk] = *(const bf16x8*)(XIN + (size_t)(qrow0 + lr) * INW + 2560 + h * 128 + 32 * kk + 8 * quad);
        float mx = -3.0e38f, lsum = 0.f;
        f32x4 O[8];
#pragma unroll
        for (int dt = 0; dt < 8; ++dt) O[dt] = (f32x4){0.f, 0.f, 0.f, 0.f};
        u32x4 kr0, kr1, vr0, vr1;
#define ATT_GLOAD(t) do { const bool lt_ = (t) < nloc; \
            const bf16_t* kp_ = XIN + (size_t)(lt_ ? (b * SEQ + (krow0 + (t)) * 64) : (MX + b * CTXL + ((t) - nloc) * 64)) * INW + 3072 + h * 128 + (size_t)krow_t * INW + kcol_t; \
            kr0 = *(const u32x4*)kp_; kr1 = *(const u32x4*)(kp_ + 8); \
            const bf16_t* vp_ = lt_ ? (VT + ((size_t)(b * 4 + h) * 128 + vrow_t) * SEQ + (krow0 + (t)) * 64 + vcol_t) : (VTC + ((size_t)(b * 4 + h) * 128 + vrow_t) * CTXL + ((t) - nloc) * 64 + vcol_t); \
            vr0 = *(const u32x4*)vp_; vr1 = *(const u32x4*)(vp_ + 8); } while (0)
#define ATT_LWRITE(slot) do { LAS bf16_t* Ks_ = (LAS bf16_t*)(lds + (slot) * A_SLOT); LAS bf16_t* Vs_ = Ks_ + 64 * AK_LD; \
            *(LAS u32x4*)(Ks_ + krow_t * AK_LD + kcol_t) = kr0; *(LAS u32x4*)(Ks_ + krow_t * AK_LD + kcol_t + 8) = kr1; \
            *(LAS u32x4*)(Vs_ + vrow_t * AV_LD + vcol_t) = vr0; *(LAS u32x4*)(Vs_ + vrow_t * AV_LD + vcol_t + 8) = vr1; } while (0)
#define ATT_STEP(sv, Vs_, kb) do { float tm_ = sv[0]; _Pragma("unroll") for (int e_ = 1; e_ < 8; ++e_) tm_ = fmaxf(tm_, sv[e_]); \
            tm_ = fmaxf(tm_, __shfl_xor(tm_, 16)); tm_ = fmaxf(tm_, __shfl_xor(tm_, 32)); \
            const float mn_ = fmaxf(mx, tm_); const float al_ = fexp(mx - mn_); mx = mn_; \
            float ps_ = 0.f; _Pragma("unroll") for (int e_ = 0; e_ < 8; ++e_) { sv[e_] = fexp(sv[e_] - mn_); ps_ += sv[e_]; } \
            lsum = lsum * al_ + ps_; \
            if (__builtin_amdgcn_ballot_w64(al_ != 1.f) != 0ull) { _Pragma("unroll") for (int dt_ = 0; dt_ < 8; ++dt_) O[dt_] *= al_; } \
            u32x4 pa_; pa_[0] = cvt_pk_bf16(sv[0], sv[1]); pa_[1] = cvt_pk_bf16(sv[2], sv[3]); pa_[2] = cvt_pk_bf16(sv[4], sv[5]); pa_[3] = cvt_pk_bf16(sv[6], sv[7]); \
            const bf16x8 paf_ = __builtin_bit_cast(bf16x8, pa_); \
            _Pragma("unroll") for (int dt_ = 0; dt_ < 8; ++dt_) { const bf16x8 vv_ = *(const LAS bf16x8*)((Vs_) + (16 * dt_ + lr) * AV_LD + (kb) + 8 * quad); \
                O[dt_] = __builtin_amdgcn_mfma_f32_16x16x32_bf16(vv_, paf_, O[dt_], 0, 0, 0); } } while (0)
        ATT_GLOAD(0); ATT_LWRITE(0);
        ATT_GLOAD(1);
        __syncthreads();
        for (int t = 0; t < T; ++t) {
            const LAS bf16_t* Ks = (const LAS bf16_t*)(lds + (t & 1) * A_SLOT); const LAS bf16_t* Vs = Ks + 64 * AK_LD;
            if (t < nloc) {
                const int kabs = krow0 + t;
                if (kabs >= rs && kabs < rs + 8) {
                    const int drow = kabs - rq + 7;
                    float sv[8];
#pragma unroll
                    for (int hf = 0; hf < 2; ++hf) {
                        const LAS bf16_t* kp = Ks + (wsc + 8 * (lr >> 2) + 4 * hf + (lr & 3)) * AK_LD + 8 * quad;
                        f32x4 a = (f32x4){0.f, 0.f, 0.f, 0.f};
#pragma unroll
                        for (int kk = 0; kk < 4; ++kk) a = __builtin_amdgcn_mfma_f32_16x16x32_bf16(*(const LAS bf16x8*)(kp + 32 * kk), qf[kk], a, 0, 0, 0);
#pragma unroll
                        for (int jj = 0; jj < 4; ++jj) {
                            const int kc = wsc + 8 * quad + 4 * hf + jj;
                            const int dcol = min(max(kc - cq + 15, 0), 30);
                            const bool ok = (kc >= cs) && (kc < cs + 16);
                            const float bv = rpb[drow * 31 + dcol];
                            sv[hf * 4 + jj] = ok ? a[jj] * scale + bv : -1e30f;
                        }
                    }
                    ATT_STEP(sv, Vs, wsc);
                }
            } else {
#pragma unroll
                for (int ks = 0; ks < 2; ++ks) {
                    float sv[8];
#pragma unroll
                    for (int hf = 0; hf < 2; ++hf) {
                        const LAS bf16_t* kp = Ks + (32 * ks + 8 * (lr >> 2) + 4 * hf + (lr & 3)) * AK_LD + 8 * quad;
                        f32x4 a = (f32x4){0.f, 0.f, 0.f, 0.f};
#pragma unroll
                        for (int kk = 0; kk < 4; ++kk) a = __builtin_amdgcn_mfma_f32_16x16x32_bf16(*(const LAS bf16x8*)(kp + 32 * kk), qf[kk], a, 0, 0, 0);
#pragma unroll
                        for (int jj = 0; jj < 4; ++jj) sv[hf * 4 + jj] = a[jj] * scale;
                    }
                    ATT_STEP(sv, Vs, 32 * ks);
                }
            }
            if (t + 1 < T) { ATT_LWRITE((t + 1) & 1); if (t + 2 < T) ATT_GLOAD(t + 2); }
            __syncthreads();
        }
#undef ATT_GLOAD
#undef ATT_LWRITE
#undef ATT_STEP
        lsum += __shfl_xor(lsum, 16); lsum += __shfl_xor(lsum, 32);
        const float linv = 1.f / lsum;
        {
            bf16_t* op = YS + (size_t)(qrow0 + lr) * D + 1536 + h * 128 + 4 * quad;
#pragma unroll
            for (int dt = 0; dt < 8; ++dt) { u32x2 o; o[0] = cvt_pk_bf16(O[dt][0] * linv, O[dt][1] * linv); o[1] = cvt_pk_bf16(O[dt][2] * linv, O[dt][3] * linv); *(u32x2*)(op + 16 * dt) = o; }
        }
    }
}

#define XB_TMO      128
#define XB_XCNT(j)  (256  + 64 * (j))
#define XB_XSUB(j)  (1280 + 64 * (j))
#define XB_XGEN(j)  (2304 + 64 * (j))
#define XB_TOP      3328
#define XB_TOPGEN   3392
#define XCD_BAR_WORDS 3456
#define XB_SPIN_CAP (1u << 18)

__device__ __forceinline__ unsigned xb_ld(unsigned* p)              { return __hip_atomic_load(p, __ATOMIC_RELAXED, __HIP_MEMORY_SCOPE_AGENT); }
__device__ __forceinline__ unsigned xb_add(unsigned* p, unsigned v) { return __hip_atomic_fetch_add(p, v, __ATOMIC_RELAXED, __HIP_MEMORY_SCOPE_AGENT); }
__device__ __forceinline__ unsigned xb_xcc_id() { return (unsigned)__builtin_amdgcn_s_getreg((3 << 11) | 20) & 0xFu; }
#define XB_SPIN(cond, bar) do { unsigned _sp = 0; while (cond) { __builtin_amdgcn_s_sleep(1); \
    if ((++_sp & 255u) == 0u) { if (xb_ld(&(bar)[XB_TMO])) break; if (_sp > XB_SPIN_CAP) { atomicAdd(&(bar)[XB_TMO], 1u); break; } } } } while (0)

struct XcdBarrier {
    unsigned* bar; unsigned x;
    volatile LAS unsigned* st;
};

__device__ __forceinline__ XcdBarrier xcd_barrier_post(unsigned* bar, volatile LAS unsigned* st) {
    XcdBarrier b; b.bar = bar; b.x = xb_xcc_id(); b.st = st;
    if (threadIdx.x == 0) (void)xb_add(&bar[XB_XCNT(b.x)], 1u);
    return b;
}
__device__ __forceinline__ void xcd_barrier_complete(unsigned* bar, unsigned x, unsigned& nloc, unsigned& nx) {
    const unsigned G = gridDim.x * gridDim.y * gridDim.z;
    unsigned sum, cnt, mine, sp = 0u;
    for (;;) {
        sum = 0u; cnt = 0u; mine = 0u;
#pragma unroll
        for (unsigned j = 0; j < 16; ++j) { const unsigned c = xb_ld(&bar[XB_XCNT(j)]); sum += c; cnt += (c > 0u) ? 1u : 0u; mine = (j == x) ? c : mine; }
        if (sum == G) break;
        __builtin_amdgcn_s_sleep(1);
        if ((++sp & 255u) == 0u) { if (xb_ld(&bar[XB_TMO])) break; if (sp > XB_SPIN_CAP) { atomicAdd(&bar[XB_TMO], 1u); break; } }
    }
    nloc = mine > 0u ? mine : 1u; nx = cnt > 0u ? cnt : 1u;
}

__device__ __forceinline__ void xcd_barrier(const XcdBarrier& b) {
    asm volatile("s_waitcnt vmcnt(0)" ::: "memory");
    __syncthreads();
    if (threadIdx.x == 0) {
        unsigned* bar = b.bar;
        __builtin_amdgcn_s_waitcnt(0);
        unsigned nloc = b.st[0], nx = b.st[1];
        if (nloc == 0u) { xcd_barrier_complete(bar, b.x, nloc, nx); b.st[0] = nloc; b.st[1] = nx; }
        const unsigned old = xb_add(&bar[XB_XSUB(b.x)], 1u);
        const unsigned gen = old / nloc;
        if (old + 1u == (gen + 1u) * nloc) {
            __builtin_amdgcn_fence(__ATOMIC_RELEASE, "agent");
            asm volatile("s_waitcnt vmcnt(0)" ::: "memory");
            const unsigned og = xb_add(&bar[XB_TOP], 1u);
            const unsigned tg = og / nx;
            if (og + 1u == (tg + 1u) * nx) xb_add(&bar[XB_TOPGEN], 1u);
            else XB_SPIN(xb_ld(&bar[XB_TOPGEN]) == tg, bar);
            __builtin_amdgcn_fence(__ATOMIC_ACQUIRE, "agent");
            xb_add(&bar[XB_XGEN(b.x)], 1u);
            asm volatile("s_waitcnt vmcnt(0)" ::: "memory");
        } else {
            XB_SPIN(xb_ld(&bar[XB_XGEN(b.x)]) == gen, bar);
            __builtin_amdgcn_fence(__ATOMIC_ACQUIRE, "agent");
            asm volatile("s_waitcnt vmcnt(0)" ::: "memory");
        }
    }
    __syncthreads();
}


typedef const __attribute__((address_space(4))) Params* KPtr;
__device__ __forceinline__ Params kparams() {
#if defined(__HIP_DEVICE_COMPILE__)
    KPtr q = (KPtr)__builtin_amdgcn_kernarg_segment_ptr(); asm volatile("" : "+s"(q)); return *q;
#else
    return Params{};
#endif
}
#define PP kparams()
__global__ void __launch_bounds__(NTHR, 2) fwd_mega(Params p_unused) {
    extern __shared__ __attribute__((aligned(16))) unsigned char smem[];
    LAS unsigned char* lds = (LAS unsigned char*)smem;
    cg::grid_group grid = cg::this_grid();
    unsigned char* ws = kparams().ws;
    volatile LAS unsigned* bst = (volatile LAS unsigned*)(lds + LDS_BYTES - 16);
    if (threadIdx.x == 0) { bst[0] = 0u; bst[1] = 0u; }
    __syncthreads();
    const XcdBarrier xbar = xcd_barrier_post((unsigned*)(ws + WS_BAR), bst);
#define GSYNC() xcd_barrier(xbar)
    bf16_t* XR = (bf16_t*)(ws + WS_XR); bf16_t* H = (bf16_t*)(ws + WS_H); bf16_t* Q = (bf16_t*)(ws + WS_Q); bf16_t* YS = (bf16_t*)(ws + WS_YS);
    const float* mod = (const float*)(ws + WS_MOD);

    phase_mod(PP, (LAS float*)lds);
    convert_layer(PP, 0, (LAS float*)lds);
    grid.sync();

#pragma unroll 1
    for (int l = 0; l < 2; ++l) {
        const bool last = l == 1;
        const float* modl = mod + (size_t)l * 9 * 12288;
        const int Mrows = last ? MX : MT;
        if (l == 0) phase_norm<true>(PP.in[I_X], PP.in[I_CTX], nullptr, PP.in[I_GMIX], modl, 0, 1, H, MT);
        else { phase_norm<false>(nullptr, nullptr, XR, PP.in[I_GMIX] + D, modl, 0, 1, H, MT); convert_layer(PP, 1, (LAS float*)lds); }
        GSYNC();
        { pg8::Gemm g{H, (const bf16_t*)(ws + WS_WIN), D, 0, MT, INW, D, 8};
          pg8::EpiStore E{Q, INW, 14, (bf16_t*)(ws + WS_VT), (bf16_t*)(ws + WS_VTC)};
          pg8::gemm_phase(lds, g, E); }
        GSYNC();
        attn_tasks(PP, l, !last, lds);
        lru_tiles(PP, l, false, false, lds);
        GSYNC();
        lru_tiles(PP, l, true, last, lds);
        pool_tiles(PP, l, last, lds);
        sgu_tiles(PP, l, last, lds);
        GSYNC();
        { pg8::Gemm g{YS, (const bf16_t*)(ws + WS_WB), D, 1024, Mrows, 8192, 512, 8};
          pg8::EpiStore E{Q, 8192, 1 << 30, nullptr, nullptr};
          pg8::gemm_phase(lds, g, E); }
        GSYNC();
        { pg8::Gemm g{H, (const bf16_t*)(ws + WS_GATE), D, 0, Mrows, 8192, D, 8};
          pg8::EpiGate E{Q, YS};
          pg8::gemm_phase(lds, g, E); }
        GSYNC();
        { pg8::Gemm g{YS, (const bf16_t*)(ws + WS_WO), D, 0, Mrows, D, D, 4};
          pg8::EpiRes E{XR, modl + 2 * 2048, l == 0 ? PP.in[I_X] : nullptr, PP.in[I_CTX]};
          pg8::gemm_phase(lds, g, E); }
        GSYNC();
        phase_norm<false>(nullptr, nullptr, XR, PP.in[I_GFFN] + (size_t)l * D, modl, 3, 4, H, Mrows);
        GSYNC();
        { pg8::Gemm g{H, (const bf16_t*)(ws + WS_GU), D, 0, Mrows, 2 * DFF, D, 8};
          pg8::EpiSwi E{Q};
          pg8::gemm_phase(lds, g, E); }
        GSYNC();
        { pg8::Gemm g{Q, (const bf16_t*)(ws + WS_WD), DFF, 0, Mrows, D, DFF, 4};
          pg8::EpiRes E{XR, modl + 5 * 2048, nullptr, nullptr};
          pg8::gemm_phase(lds, g, E); }
        GSYNC();
    }
    phase_final(XR, PP.in[I_GFINAL], PP.out);
}

extern "C" void kernel_launch(void* const* d_in, const int* in_sizes, int n_in, void* d_out, int out_size, void* d_ws, size_t ws_size, hipStream_t stream) {
    static int grid = 0;
    if (grid == 0) {
        if (n_in != 29 || ws_size < WS_END) { fprintf(stderr, "kernel_launch: n_in %d ws %zu need %zu\n", n_in, ws_size, (size_t)WS_END); grid = -1; return; }
        int dev = 0, cus = 0, per_cu = 0;
        hipGetDevice(&dev);
        hipDeviceGetAttribute(&cus, hipDeviceAttributeMultiprocessorCount, dev);
        hipFuncSetAttribute((const void*)fwd_mega, hipFuncAttributeMaxDynamicSharedMemorySize, LDS_BYTES);
        hipOccupancyMaxActiveBlocksPerMultiprocessor(&per_cu, (const void*)fwd_mega, NTHR, LDS_BYTES);
        if (per_cu < 1) { fprintf(stderr, "kernel_launch: occupancy query says %d blocks/CU\n", per_cu); per_cu = 1; }
        grid = cus * 1;
        (void)hipGetLastError();
    }
    if (grid < 0) return;
    Params p{};
    for (int i = 0; i < 29; ++i) p.in[i] = (const float*)d_in[i];
    p.out = (float*)d_out; p.ws = (unsigned char*)d_ws;
    (void)hipMemsetAsync((unsigned char*)d_ws + WS_BAR, 0, 3456 * 4, stream);
    void* args[] = {&p};
    hipError_t e = hipLaunchCooperativeKernel((const void*)fwd_mega, dim3(grid), dim3(NTHR), args, LDS_BYTES, stream);
    if (e != hipSuccess) fprintf(stderr, "cooperative launch failed: %s (grid %d)\n", hipGetErrorString(e), grid);
}
```
